# Optimizing an MI355X kernel written in HIP

```python
import jax, jax.numpy as jnp
from jax import lax
import numpy as np

D_MODEL = 1024
BATCH = 16
SEQ = 256
DEPTH = 1
DEC_BATCH = 2
DEC_SEQ = 1024
PAST_LEN = 512

GRID_W = 64
HEAD_DIM = 64
GLA_HEADS = 8
GLA_DK = 64
GLA_DV = 64
GLA_WIDTH = GLA_HEADS * GLA_DV
GATE_RANK = 16
GATE_TEMP = 16.0
GLA_CHUNK = 64
SWA_HEADS = 8
SWA_KV_HEADS = 2
SWA_GROUP = SWA_HEADS // SWA_KV_HEADS
SWA_WIDTH = SWA_HEADS * HEAD_DIM
WINDOW = 128
BLOCK = 128
MIX_WIDTH = GLA_WIDTH + SWA_WIDTH
D_FF = 4 * D_MODEL
ROPE_THETA = 10000.0
ROPE_AXIS_DIM = HEAD_DIM // 2
EPS = 1e-6
NEG_INF = -1e30
SPLIT_SIZES = (GLA_HEADS * GLA_DK, GLA_HEADS * GLA_DK, GLA_WIDTH, GLA_WIDTH, 2 * GATE_RANK,
               SWA_WIDTH, SWA_KV_HEADS * HEAD_DIM, SWA_KV_HEADS * HEAD_DIM)
D_IN = 2 * GLA_HEADS * GLA_DK + 2 * GLA_WIDTH + 2 * GATE_RANK + SWA_WIDTH + 2 * SWA_KV_HEADS * HEAD_DIM

kernel_name = "hybrid_gla_swa_prefix_diffusion_step"


def rmsnorm(x, gain):
    xf = x.astype(jnp.float32)
    xf = xf * lax.rsqrt(jnp.mean(xf * xf, axis=-1, keepdims=True) + EPS)
    return xf.astype(x.dtype) * gain


def modulation(cond, w_ada, b_ada):
    m = jax.nn.silu(cond) @ w_ada + b_ada
    return jnp.split(m[:, None, :], 6, axis=-1)


def adaln(x, gain, shift, scale):
    return rmsnorm(x, gain) * (1.0 + scale) + shift


def axial_rope(T):
    rows = T // GRID_W
    t = jnp.arange(rows * GRID_W)
    row = (t // GRID_W).astype(jnp.float32)
    col = (t % GRID_W).astype(jnp.float32)
    half = ROPE_AXIS_DIM // 2
    freqs = ROPE_THETA ** (-jnp.arange(half, dtype=jnp.float32) / half)
    ang_r = row[:, None] * freqs[None, :]
    ang_c = col[:, None] * freqs[None, :]
    return (jnp.cos(ang_r), jnp.sin(ang_r), jnp.cos(ang_c), jnp.sin(ang_c))


def _rotate(x, cos, sin):
    x1, x2 = jnp.split(x, 2, axis=-1)
    return jnp.concatenate([x1 * cos - x2 * sin, x2 * cos + x1 * sin], axis=-1)


def apply_rope(x, rope):
    cos_r, sin_r, cos_c, sin_c = rope
    xr, xc = x[..., :ROPE_AXIS_DIM], x[..., ROPE_AXIS_DIM:]
    out = jnp.concatenate([_rotate(xr, cos_r, sin_r), _rotate(xc, cos_c, sin_c)], axis=-1)
    return out.astype(x.dtype)


def project(h, w_in, w_gk_f, b_gk_f, w_gk_b, b_gk_b, q_norm, k_norm):
    B, T, _ = h.shape
    idx, acc = [], 0
    for s in SPLIT_SIZES[:-1]:
        acc += s
        idx.append(acc)
    gq, gk, gv, gg, glr, sq, sk, sv = jnp.split(h @ w_in, idx, axis=-1)

    def heads(t, n):
        return t.reshape(B, T, n, -1).transpose(0, 2, 1, 3)

    gq = heads(gq, GLA_HEADS) * (GLA_DK ** -0.5)
    gk = heads(gk, GLA_HEADS)
    gv = heads(gv, GLA_HEADS)
    lr_f, lr_b = jnp.split(glr, 2, axis=-1)
    g_f = heads(jax.nn.log_sigmoid(lr_f @ w_gk_f + b_gk_f) / GATE_TEMP, GLA_HEADS)
    g_b = heads(jax.nn.log_sigmoid(lr_b @ w_gk_b + b_gk_b) / GATE_TEMP, GLA_HEADS)
    sq = rmsnorm(heads(sq, SWA_HEADS), q_norm).reshape(B, SWA_KV_HEADS, SWA_GROUP, T, HEAD_DIM)
    sk = rmsnorm(heads(sk, SWA_KV_HEADS), k_norm)
    sv = heads(sv, SWA_KV_HEADS)
    return (gq, gk, gv, g_f, g_b), (sq, sk, sv), gg


def gla_scan(q, k, v, g, s0):
    B, H, T, DK = q.shape
    DV = v.shape[-1]
    n = T // GLA_CHUNK

    def chunks(t):
        return jnp.moveaxis(t.reshape(B, H, n, GLA_CHUNK, t.shape[-1]), 2, 0)

    causal = jnp.tril(jnp.ones((GLA_CHUNK, GLA_CHUNK), dtype=bool))[:, :, None]

    def step(S, inp):
        qc, kc, vc, gc = inp
        b = jnp.cumsum(gc.astype(jnp.float32), axis=2)
        rel = jnp.where(causal, b[:, :, :, None, :] - b[:, :, None, :, :], -jnp.inf)
        decay = jnp.exp(rel)
        A = jnp.einsum('bhid,bhjd,bhijd->bhij', qc, kc, decay)
        o = (jnp.einsum('bhid,bhde->bhie', qc * jnp.exp(b), S)
             + jnp.einsum('bhij,bhje->bhie', A, vc))
        b_last = b[:, :, -1:, :]
        S = (jnp.exp(b_last[:, :, 0, :])[..., None] * S
             + jnp.einsum('bhjd,bhje->bhde', kc * jnp.exp(b_last - b), vc))
        return S, o

    S, o = lax.scan(step, s0.astype(jnp.float32), (chunks(q), chunks(k), chunks(v), chunks(g)))
    o = jnp.moveaxis(o, 0, 2).reshape(B, H, T, DV)
    return o.astype(v.dtype), S


def gla_bidirectional(q, k, v, g_f, g_b, s0_f, s0_b):
    o_f, s_f = gla_scan(q, k, v, g_f, s0_f)
    flip = lambda t: jnp.flip(t, axis=2)
    o_b, s_b = gla_scan(flip(q), flip(k), flip(v), flip(g_b), s0_b)
    return o_f + flip(o_b), s_f, s_b


def softmax_with_sink(s, sink):
    sk = jnp.broadcast_to(sink.astype(jnp.float32).reshape(1, SWA_KV_HEADS, SWA_GROUP, 1, 1),
                          s.shape[:-1] + (1,))
    p = jax.nn.softmax(jnp.concatenate([s, sk], axis=-1), axis=-1)
    return p[..., :-1]


def context_attention(q, k, v, sink):
    B, KVH, G, Lc, D = q.shape
    scale = HEAD_DIM ** -0.5

    def blk(i):
        qb = lax.dynamic_slice_in_dim(q, i * BLOCK, BLOCK, axis=3)
        s = jnp.einsum('bkgqd,bksd->bkgqs', qb, k).astype(jnp.float32) * scale
        p = softmax_with_sink(s, sink).astype(v.dtype)
        return jnp.einsum('bkgqs,bksd->bkgqd', p, v)

    o = lax.map(blk, jnp.arange(Lc // BLOCK))
    return jnp.moveaxis(o, 0, 3).reshape(B, KVH, G, Lc, D)


def latent_attention(q, k, v, kc, vc, sink):
    B, KVH, G, T, D = q.shape
    scale = HEAD_DIM ** -0.5
    span = BLOCK + 2 * WINDOW
    pad = ((0, 0), (0, 0), (WINDOW, WINDOW), (0, 0))
    kp, vp = jnp.pad(k, pad), jnp.pad(v, pad)

    def blk(i):
        qb = lax.dynamic_slice_in_dim(q, i * BLOCK, BLOCK, axis=3)
        kb = lax.dynamic_slice_in_dim(kp, i * BLOCK, span, axis=2)
        vb = lax.dynamic_slice_in_dim(vp, i * BLOCK, span, axis=2)
        qpos = i * BLOCK + jnp.arange(BLOCK)
        kpos = i * BLOCK - WINDOW + jnp.arange(span)
        valid = ((jnp.abs(qpos[:, None] - kpos[None, :]) <= WINDOW)
                 & (kpos[None, :] >= 0) & (kpos[None, :] < T))
        s_loc = jnp.einsum('bkgqd,bksd->bkgqs', qb, kb).astype(jnp.float32) * scale
        s_loc = jnp.where(valid, s_loc, NEG_INF)
        s_ctx = jnp.einsum('bkgqd,bksd->bkgqs', qb, kc).astype(jnp.float32) * scale
        p = softmax_with_sink(jnp.concatenate([s_loc, s_ctx], axis=-1), sink).astype(v.dtype)
        return (jnp.einsum('bkgqs,bksd->bkgqd', p[..., :span], vb)
                + jnp.einsum('bkgqs,bksd->bkgqd', p[..., span:], vc))

    o = lax.map(blk, jnp.arange(T // BLOCK))
    return jnp.moveaxis(o, 0, 3).reshape(B, KVH, G, T, D)


def merge(o_gla, gg, gla_norm, o_swa, w_o):
    B, H, T, DV = o_gla.shape
    og = rmsnorm(o_gla.transpose(0, 2, 1, 3), gla_norm).reshape(B, T, GLA_WIDTH) * jax.nn.silu(gg)
    osw = o_swa.transpose(0, 3, 1, 2, 4).reshape(B, T, SWA_WIDTH)
    return jnp.concatenate([og, osw], axis=-1) @ w_o


def sq_relu_mlp(h, w1, w2):
    return jnp.square(jax.nn.relu(h @ w1)) @ w2


def setup_inputs(seed: int = 0) -> dict:
    key = jax.random.key(seed)
    ks = jax.random.split(key, 26)
    nrm = lambda k, shape, s: jax.random.normal(k, shape, jnp.float32) * s
    gain = lambda k, shape: 1.0 + nrm(k, shape, 0.02)
    L = DEPTH
    return {
        "x_prompt": nrm(ks[0], (BATCH, SEQ, D_MODEL), 1.0),
        "x_sample": nrm(ks[1], (DEC_BATCH, DEC_SEQ, D_MODEL), 1.0),
        "c": nrm(ks[2], (DEC_BATCH, D_MODEL), 1.0),
        "cache_k": nrm(ks[3], (DEC_BATCH, L, SWA_KV_HEADS, PAST_LEN, HEAD_DIM), 1.0),
        "cache_v": nrm(ks[4], (DEC_BATCH, L, SWA_KV_HEADS, PAST_LEN, HEAD_DIM), 1.0),
        "state_gla_fwd": nrm(ks[5], (DEC_BATCH, L, GLA_HEADS, GLA_DK, GLA_DV), 0.3),
        "state_gla_bwd": nrm(ks[6], (DEC_BATCH, L, GLA_HEADS, GLA_DK, GLA_DV), 0.3),
        "c_ctx": nrm(ks[7], (D_MODEL,), 1.0),
        "w_ada": nrm(ks[8], (L, D_MODEL, 6 * D_MODEL), 0.5 * D_MODEL ** -0.5),
        "b_ada": nrm(ks[9], (L, 6 * D_MODEL), 0.02),
        "norm_mix": gain(ks[10], (L, D_MODEL)),
        "norm_ff": gain(ks[11], (L, D_MODEL)),
        "w_in": nrm(ks[12], (L, D_MODEL, D_IN), D_MODEL ** -0.5),
        "w_gk_fwd": nrm(ks[13], (L, GATE_RANK, GLA_HEADS * GLA_DK), GATE_RANK ** -0.5),
        "b_gk_fwd": nrm(ks[14], (L, GLA_HEADS * GLA_DK), 0.1),
        "w_gk_bwd": nrm(ks[15], (L, GATE_RANK, GLA_HEADS * GLA_DK), GATE_RANK ** -0.5),
        "b_gk_bwd": nrm(ks[16], (L, GLA_HEADS * GLA_DK), 0.1),
        "gla_norm": gain(ks[17], (L, GLA_DV)),
        "q_norm": gain(ks[18], (L, HEAD_DIM)),
        "k_norm": gain(ks[19], (L, HEAD_DIM)),
        "sink": nrm(ks[20], (L, SWA_HEADS), 0.5),
        "w_o": nrm(ks[21], (L, MIX_WIDTH, D_MODEL), MIX_WIDTH ** -0.5),
        "w_ff1": nrm(ks[22], (L, D_MODEL, D_FF), D_MODEL ** -0.5),
        "w_ff2": nrm(ks[23], (L, D_FF, D_MODEL), D_FF ** -0.5),
    }


def reference(x_prompt, x_sample, c, cache_k, cache_v, state_gla_fwd, state_gla_bwd, c_ctx,
              w_ada, b_ada, norm_mix, norm_ff, w_in, w_gk_fwd, b_gk_fwd, w_gk_bwd, b_gk_bwd,
              gla_norm, q_norm, k_norm, sink, w_o, w_ff1, w_ff2):
    rope = axial_rope(x_sample.shape[1])
    xp, xs = x_prompt, x_sample
    new_k, new_v, new_sf, new_sb = [], [], [], []
    for l in range(DEPTH):
        proj_w = (w_in[l], w_gk_fwd[l], b_gk_fwd[l], w_gk_bwd[l], b_gk_bwd[l], q_norm[l], k_norm[l])

        sh1, sc1, g1, sh2, sc2, g2 = modulation(c_ctx[None, :], w_ada[l], b_ada[l])
        h = adaln(xp, norm_mix[l], sh1, sc1)
        (gq, gk, gv, gf, gb), (sq, sk, sv), gg = project(h, *proj_w)
        zeros = jnp.zeros((xp.shape[0], GLA_HEADS, GLA_DK, GLA_DV), jnp.float32)
        o_gla, s_f, s_b = gla_bidirectional(gq, gk, gv, gf, gb, zeros, zeros)
        o_swa = context_attention(sq, sk, sv, sink[l])
        xp = xp + g1 * merge(o_gla, gg, gla_norm[l], o_swa, w_o[l])
        h = adaln(xp, norm_ff[l], sh2, sc2)
        xp = xp + g2 * sq_relu_mlp(h, w_ff1[l], w_ff2[l])
        new_k.append(sk)
        new_v.append(sv)
        new_sf.append(s_f.astype(xp.dtype))
        new_sb.append(s_b.astype(xp.dtype))

        sh1, sc1, g1, sh2, sc2, g2 = modulation(c, w_ada[l], b_ada[l])
        h = adaln(xs, norm_mix[l], sh1, sc1)
        (gq, gk, gv, gf, gb), (sq, sk, sv), gg = project(h, *proj_w)
        sq = apply_rope(sq, rope)
        sk = apply_rope(sk, rope)
        o_gla, _, _ = gla_bidirectional(gq, gk, gv, gf, gb, state_gla_fwd[:, l], state_gla_bwd[:, l])
        o_swa = latent_attention(sq, sk, sv, cache_k[:, l], cache_v[:, l], sink[l])
        xs = xs + g1 * merge(o_gla, gg, gla_norm[l], o_swa, w_o[l])
        h = adaln(xs, norm_ff[l], sh2, sc2)
        xs = xs + g2 * sq_relu_mlp(h, w_ff1[l], w_ff2[l])

    return (xp, xs, jnp.stack(new_k, axis=1), jnp.stack(new_v, axis=1),
            jnp.stack(new_sf, axis=1), jnp.stack(new_sb, axis=1))
```

```cpp
#include <hip/hip_runtime.h>
#include <hip/hip_cooperative_groups.h>
#include <cstdio>
namespace cg = cooperative_groups;

typedef unsigned short u16;

#define NTOK 6144
#define NCTX 4096
#define DM 1024
#define DFF 4096
#define NPROJ 2944
#define MODN 6144
#define XCD_BAR_WORDS 3456

struct P {
  const float *xp, *xs, *c, *cache_k, *cache_v, *sgf, *sgb, *cctx, *w_ada, *b_ada, *norm_mix, *norm_ff,
      *w_in, *wgf, *bgf, *wgb, *bgb, *gla_norm, *q_norm, *k_norm, *sink, *w_o, *w1, *w2;
  float* out;
  u16 *WinT, *WoT, *W1T, *W2T, *hbuf, *gq, *gk, *gvT, *gg, *sq, *sk, *svT, *ckb, *cvT, *act, *hid;
  float *mod, *mod2, *lr, *dS, *dec, *Bst;
  u16* x1;
  float2* rope;
  unsigned* bar;
  int never, pad_;
};

__device__ __forceinline__ u16 f2bf(float f) {
  unsigned u = __float_as_uint(f);
  u += 0x7fffu + ((u >> 16) & 1u);
  return (u16)(u >> 16);
}
__device__ __forceinline__ float bf2f(u16 h) { return __uint_as_float(((unsigned)h) << 16); }
__device__ __forceinline__ float bflo(unsigned w) { return __uint_as_float(w << 16); }
__device__ __forceinline__ float bfhi(unsigned w) { return __uint_as_float(w & 0xffff0000u); }
typedef __attribute__((ext_vector_type(2))) __bf16 bf2_t;
typedef __attribute__((ext_vector_type(2))) float f2_t;
__device__ __forceinline__ unsigned pack2(float a, float b) {
  f2_t v = {a, b};
  bf2_t r = __builtin_convertvector(v, bf2_t);
  return __builtin_bit_cast(unsigned, r);
}
__device__ __forceinline__ float silu_f(float x) { return x / (1.f + expf(-x)); }
__device__ __forceinline__ float logsig_f(float x) { return fminf(x, 0.f) - __logf(1.f + __expf(-fabsf(x))); }
__device__ __forceinline__ float wave_sum(float v) {
#pragma unroll
  for (int o = 32; o >= 1; o >>= 1) v += __shfl_xor(v, o);
  return v;
}
__device__ __forceinline__ float wave_max(float v) {
#pragma unroll
  for (int o = 32; o >= 1; o >>= 1) v = fmaxf(v, __shfl_xor(v, o));
  return v;
}
typedef float f4v __attribute__((ext_vector_type(4)));
__device__ __forceinline__ float4 ld_nt4(const float* p) { f4v v = __builtin_nontemporal_load((const f4v*)p); return make_float4(v.x, v.y, v.z, v.w); }
__device__ __forceinline__ void st_nt(float* p, float v) { __builtin_nontemporal_store(v, p); }
__device__ __forceinline__ int opaque_tid() { int t = threadIdx.x; asm volatile("" : "+v"(t)); return t; }
__device__ __forceinline__ int tok_cond(int t) { return t < NCTX ? 0 : 1 + ((t - NCTX) >> 10); }
__device__ __forceinline__ const float* xrow(const P& p, int t) {
  return t < NCTX ? p.xp + (size_t)t * DM : p.xs + (size_t)(t - NCTX) * DM;
}
__device__ __forceinline__ void tok_seq(int t, int& tok0, int& T, int& s) {
  if (t < NCTX) { tok0 = t & ~255; T = 256; s = t & 255; }
  else { int u = t - NCTX; tok0 = NCTX + (u & ~1023); T = 1024; s = u & 1023; }
}

__device__ void mod_item(const P& p, int it, float* sm, int khalf = -1) {
  float* ssil = sm;
  float* red = sm + 3072;
  const int tid = opaque_tid(), lane = tid & 63, w = tid >> 6;
  for (int i = tid; i < 3072; i += 256) {
    int cd = i >> 10, k = i & 1023;
    float v = cd == 0 ? p.cctx[k] : p.c[(cd - 1) * 1024 + k];
    ssil[i] = silu_f(v);
  }
  __syncthreads();
  const int n0 = it * 32, cl = lane & 7, rg = lane >> 3;
  float a0[4] = {0, 0, 0, 0}, a1[4] = {0, 0, 0, 0}, a2[4] = {0, 0, 0, 0};
  const int kbase = khalf < 0 ? w * 256 : khalf * 512 + w * 128, niter = khalf < 0 ? 32 : 16;
#pragma unroll 16
  for (int i = 0; i < niter; i++) {
    int k = kbase + i * 8 + rg;
    float4 wv = ld_nt4(p.w_ada + (size_t)k * MODN + n0 + cl * 4);
    float s0 = ssil[k], s1 = ssil[1024 + k], s2 = ssil[2048 + k];
    a0[0] += s0 * wv.x; a0[1] += s0 * wv.y; a0[2] += s0 * wv.z; a0[3] += s0 * wv.w;
    a1[0] += s1 * wv.x; a1[1] += s1 * wv.y; a1[2] += s1 * wv.z; a1[3] += s1 * wv.w;
    a2[0] += s2 * wv.x; a2[1] += s2 * wv.y; a2[2] += s2 * wv.z; a2[3] += s2 * wv.w;
  }
#pragma unroll
  for (int j = 0; j < 4; j++) {
    a0[j] += __shfl_xor(a0[j], 8); a0[j] += __shfl_xor(a0[j], 16); a0[j] += __shfl_xor(a0[j], 32);
    a1[j] += __shfl_xor(a1[j], 8); a1[j] += __shfl_xor(a1[j], 16); a1[j] += __shfl_xor(a1[j], 32);
    a2[j] += __shfl_xor(a2[j], 8); a2[j] += __shfl_xor(a2[j], 16); a2[j] += __shfl_xor(a2[j], 32);
  }
  if (rg == 0) {
#pragma unroll
    for (int j = 0; j < 4; j++) {
      red[(w * 3 + 0) * 32 + cl * 4 + j] = a0[j];
      red[(w * 3 + 1) * 32 + cl * 4 + j] = a1[j];
      red[(w * 3 + 2) * 32 + cl * 4 + j] = a2[j];
    }
  }
  __syncthreads();
  if (tid < 96) {
    int cd = tid >> 5, col = tid & 31;
    float v = khalf == 1 ? 0.f : p.b_ada[n0 + col];
    for (int ww = 0; ww < 4; ww++) v += red[(ww * 3 + cd) * 32 + col];
    if (khalf == 1) p.mod2[cd * 2048 + n0 + col] = v;
    else p.mod[cd * MODN + n0 + col] = v;
  }
  __syncthreads();
}

__device__ void conv_tile(const float* src, int ldsrc, int k0, int nsrc0, int nvalid, u16* dst, int nd0, int Kd, float* tile) {
  const int tid = opaque_tid();
#pragma unroll
  for (int i = 0; i < 4; i++) {
    int idx = tid + 256 * i;
    int r = idx >> 4, c4 = (idx & 15) * 4;
    float4 v = make_float4(0.f, 0.f, 0.f, 0.f);
    if (c4 < nvalid) v = ld_nt4(src + (size_t)(k0 + r) * ldsrc + nsrc0 + c4);
    tile[r * 65 + c4 + 0] = v.x; tile[r * 65 + c4 + 1] = v.y; tile[r * 65 + c4 + 2] = v.z; tile[r * 65 + c4 + 3] = v.w;
  }
  __syncthreads();
#pragma unroll
  for (int i = 0; i < 2; i++) {
    int id = tid + 256 * i;
    int n = id >> 3, kc = id & 7;
    float f[8];
#pragma unroll
    for (int j = 0; j < 8; j++) f[j] = tile[(kc * 8 + j) * 65 + n];
    uint4 o;
    o.x = pack2(f[0], f[1]); o.y = pack2(f[2], f[3]); o.z = pack2(f[4], f[5]); o.w = pack2(f[6], f[7]);
    *(uint4*)(dst + (size_t)(nd0 + n) * Kd + k0 + kc * 8) = o;
  }
  __syncthreads();
}

__device__ void conv_tile2(const float* src, int ldsrc, int k0, int nsrc0, int nvalid, u16* dst, int nd0, int Kd, float* tile) {
  const int tid = opaque_tid();
  float4 v[8];
#pragma unroll
  for (int j = 0; j < 8; j++) {
    const int idx = tid + 256 * j, r = idx >> 4, c4 = (idx & 15) * 4;
    v[j] = make_float4(0.f, 0.f, 0.f, 0.f);
    if (c4 < nvalid) v[j] = ld_nt4(src + (size_t)(k0 + r) * ldsrc + nsrc0 + c4);
  }
#pragma unroll
  for (int half = 0; half < 2; half++) {
#pragma unroll
    for (int i = 0; i < 4; i++) {
      const int j = half * 4 + i, idx = tid + 256 * j, r = (idx >> 4) - 64 * half, c4 = (idx & 15) * 4;
      tile[r * 65 + c4 + 0] = v[j].x; tile[r * 65 + c4 + 1] = v[j].y; tile[r * 65 + c4 + 2] = v[j].z; tile[r * 65 + c4 + 3] = v[j].w;
    }
    __syncthreads();
#pragma unroll
    for (int i = 0; i < 2; i++) {
      const int id = tid + 256 * i, n = id >> 3, kc = id & 7;
      float f[8];
#pragma unroll
      for (int jj = 0; jj < 8; jj++) f[jj] = tile[(kc * 8 + jj) * 65 + n];
      uint4 o;
      o.x = pack2(f[0], f[1]); o.y = pack2(f[2], f[3]); o.z = pack2(f[4], f[5]); o.w = pack2(f[6], f[7]);
      *(uint4*)(dst + (size_t)(nd0 + n) * Kd + k0 + half * 64 + kc * 8) = o;
    }
    __syncthreads();
  }
}

#define N_MOD0_ITEMS 128
#define N_MOD1_ITEMS 128
#define N_WIN_ITEMS (8 * 46)
#define N_WO_ITEMS (8 * 16)
#define N_W1_ITEMS (8 * 64)
#define N_W2_ITEMS (32 * 16)
#define N_CV_ITEMS 32
#define N_CK_ITEMS 32
#define N_P0_ITEMS (N_MOD0_ITEMS + N_WIN_ITEMS + N_CV_ITEMS + N_CK_ITEMS + 1)
#define N_Q_ITEMS (N_MOD1_ITEMS + N_WO_ITEMS + N_W1_ITEMS + N_W2_ITEMS)

__device__ void phase0(const P& p, int bid, int nblk, float* sm) {
  for (int it = bid; it < N_P0_ITEMS; it += nblk) {
    int i = it;
    if (i < N_MOD0_ITEMS) { mod_item(p, i >> 1, sm, i & 1); continue; }
    i -= N_MOD0_ITEMS;
    if (i < N_WIN_ITEMS) {
      int kt = i & 7, nt = i >> 3;
      int nd0 = nt * 64, nsrc0, nvalid;
      if (nd0 < 2048) { nsrc0 = nd0; nvalid = 64; }
      else if (nd0 < 2816) { nsrc0 = nd0 + 32; nvalid = 64; }
      else if (nd0 == 2816) { nsrc0 = 2048; nvalid = 32; }
      else { nsrc0 = 0; nvalid = 0; }
      conv_tile2(p.w_in, 2848, kt * 128, nsrc0, nvalid, p.WinT, nd0, 1024, sm);
      continue;
    }
    i -= N_WIN_ITEMS;
    if (i < N_CV_ITEMS) {
      int bk = i >> 3, st = i & 7;
      conv_tile(p.cache_v + (size_t)bk * 512 * 64, 64, st * 64, 0, 64, p.cvT + (size_t)bk * 64 * 512, 0, 512, sm);
      continue;
    }
    i -= N_CV_ITEMS;
    if (i == N_CK_ITEMS) {
#pragma unroll
      for (int j = 0; j < 4; j++) {
        int idx = threadIdx.x + 256 * j;
        float freq = powf(10000.f, -(float)(idx & 15) / 16.f);
        float ang = (float)(idx >> 4) * freq;
        float sn, cs;
        sincosf(ang, &sn, &cs);
        p.rope[idx] = make_float2(cs, sn);
      }
      continue;
    }
    {
      int base = i * 4096 + threadIdx.x * 16;
#pragma unroll
      for (int j = 0; j < 4; j++) {
        float4 v = *(const float4*)(p.cache_k + base + j * 4);
        uint2 o; o.x = pack2(v.x, v.y); o.y = pack2(v.z, v.w);
        *(uint2*)(p.ckb + base + j * 4) = o;
      }
    }
  }
}

#define QWORDS0 (XCD_BAR_WORDS + 64)
#define QWORDS1 (XCD_BAR_WORDS + 64 + 512)
#define BAR_WORDS_TOTAL (XCD_BAR_WORDS + 64 + 1024)
__device__ void phase_queue(const P& p, float* sm, volatile unsigned* slot) {
  const int nsh = (gridDim.x & 7) == 0 ? 8 : 1, sh = nsh == 8 ? (int)(blockIdx.x & 7) : 0;
  unsigned* ctr = p.bar + QWORDS0 + sh * 64;
  unsigned nxt = 0;
  if (threadIdx.x == 0) nxt = atomicAdd(ctr, 1u);
  for (;;) {
    __syncthreads();
    if (threadIdx.x == 0) *slot = nxt;
    __syncthreads();
    int i = (int)*slot * nsh + sh;
    if (i >= N_Q_ITEMS) break;
    if (threadIdx.x == 0) nxt = atomicAdd(ctr, 1u);
    if (i < N_MOD1_ITEMS) { mod_item(p, 64 + i, sm); continue; }
    i -= N_MOD1_ITEMS;
    if (i < N_WO_ITEMS) { int kt = i & 7, nt = i >> 3; conv_tile2(p.w_o, 1024, kt * 128, nt * 64, 64, p.WoT, nt * 64, 1024, sm); continue; }
    i -= N_WO_ITEMS;
    if (i < N_W1_ITEMS) { int kt = i & 7, nt = i >> 3; conv_tile2(p.w1, 4096, kt * 128, nt * 64, 64, p.W1T, nt * 64, 1024, sm); continue; }
    i -= N_W1_ITEMS;
    { int kt = i & 31, nt = i >> 5; conv_tile2(p.w2, 1024, kt * 128, nt * 64, 64, p.W2T, nt * 64, 4096, sm); }
  }
}

__device__ void adaln_pass(const P& p, int which, int bid, int nblk) {
  const int lane = threadIdx.x & 63, w = threadIdx.x >> 6;
  const float* gain = which ? p.norm_ff : p.norm_mix;
  for (int t = bid * 4 + w; t < NTOK; t += nblk * 4) {
    const float* md = p.mod + tok_cond(t) * MODN + (which ? 3072 : 0);
    float v[16];
    if (which) {
#pragma unroll
      for (int i = 0; i < 2; i++) {
        const uint4 u = *(const uint4*)(p.x1 + (size_t)t * DM + i * 512 + lane * 8);
        v[i * 8 + 0] = bflo(u.x); v[i * 8 + 1] = bfhi(u.x); v[i * 8 + 2] = bflo(u.y); v[i * 8 + 3] = bfhi(u.y);
        v[i * 8 + 4] = bflo(u.z); v[i * 8 + 5] = bfhi(u.z); v[i * 8 + 6] = bflo(u.w); v[i * 8 + 7] = bfhi(u.w);
      }
    } else {
      const float* x = xrow(p, t);
#pragma unroll
      for (int i = 0; i < 2; i++) {
        const float4 a = ld_nt4(x + i * 512 + lane * 8), b = ld_nt4(x + i * 512 + lane * 8 + 4);
        v[i * 8 + 0] = a.x; v[i * 8 + 1] = a.y; v[i * 8 + 2] = a.z; v[i * 8 + 3] = a.w;
        v[i * 8 + 4] = b.x; v[i * 8 + 5] = b.y; v[i * 8 + 6] = b.z; v[i * 8 + 7] = b.w;
      }
    }
    float ss = 0.f;
#pragma unroll
    for (int j = 0; j < 16; j++) ss += v[j] * v[j];
    ss = wave_sum(ss);
    const float rstd = rsqrtf(ss * (1.f / 1024.f) + 1e-6f);
#pragma unroll
    for (int i = 0; i < 2; i++) {
      const int col = i * 512 + lane * 8;
      float o[8];
#pragma unroll
      for (int h = 0; h < 2; h++) {
        const float4 g = *(const float4*)(gain + col + 4 * h);
        float4 sh = *(const float4*)(md + col + 4 * h);
        float4 sc = *(const float4*)(md + 1024 + col + 4 * h);
        if (!which) {
          const float* m2 = p.mod2 + tok_cond(t) * 2048;
          const float4 sh2 = *(const float4*)(m2 + col + 4 * h), sc2 = *(const float4*)(m2 + 1024 + col + 4 * h);
          sh.x += sh2.x; sh.y += sh2.y; sh.z += sh2.z; sh.w += sh2.w;
          sc.x += sc2.x; sc.y += sc2.y; sc.z += sc2.z; sc.w += sc2.w;
        }
        o[4 * h + 0] = v[i * 8 + 4 * h + 0] * rstd * g.x * (1.f + sc.x) + sh.x;
        o[4 * h + 1] = v[i * 8 + 4 * h + 1] * rstd * g.y * (1.f + sc.y) + sh.y;
        o[4 * h + 2] = v[i * 8 + 4 * h + 2] * rstd * g.z * (1.f + sc.z) + sh.z;
        o[4 * h + 3] = v[i * 8 + 4 * h + 3] * rstd * g.w * (1.f + sc.w) + sh.w;
      }
      uint4 ov;
      ov.x = pack2(o[0], o[1]); ov.y = pack2(o[2], o[3]); ov.z = pack2(o[4], o[5]); ov.w = pack2(o[6], o[7]);
      *(uint4*)(p.hbuf + (size_t)t * DM + col) = ov;
    }
  }
}

using bf16x8 = __attribute__((ext_vector_type(8))) short;
using f32x16 = __attribute__((ext_vector_type(16))) float;
#define MFMA32(a, b, c) __builtin_amdgcn_mfma_f32_32x32x16_bf16((a), (b), (c), 0, 0, 0)
__device__ __forceinline__ int swz(int row, int ch) { return row * 128 + ((ch ^ ((row >> 1) & 7)) << 4); }
__device__ __forceinline__ int crow(int reg, int hh) { return (reg & 3) + 8 * (reg >> 2) + 4 * hh; }

template <int MI, int NI, int WM, int WN, class Epi>
__device__ void gemm_mfma(const u16* __restrict__ A, const u16* __restrict__ Bt, int M, int N, int K, const Epi& epi,
                          int bid, int nblk, char* smem) {
  constexpr int BM = 32 * MI * WM, BN = 32 * NI * WN, LA = BM / 32, LB = BN / 32;
  static_assert(WM * WN == 4 && BM <= 128 && BN <= 128, "tile");
  const int tid = opaque_tid(), lane = tid & 63, wv = tid >> 6, wm = wv / WN, wn = wv % WN;
  const int tm = M / BM, tn = N / BN, KT = K >> 6;
  const int lr = lane & 31, lh = lane >> 5;
  const int lrow = tid >> 3, lch = tid & 7;
  for (int it = bid; it < tm * tn; it += nblk) {
    const int mt = it % tm, nt = it / tm;
    const u16* Ag = A + (size_t)(mt * BM + lrow) * K + lch * 8;
    const u16* Bg = Bt + (size_t)(nt * BN + lrow) * K + lch * 8;
    f32x16 acc[MI][NI];
#pragma unroll
    for (int mi = 0; mi < MI; mi++)
#pragma unroll
      for (int ni = 0; ni < NI; ni++)
#pragma unroll
        for (int r = 0; r < 16; r++) acc[mi][ni][r] = 0.f;
    uint4 ra[LA], rb[LB];
#pragma unroll
    for (int i = 0; i < LA; i++) ra[i] = *(const uint4*)(Ag + (size_t)(32 * i) * K);
#pragma unroll
    for (int i = 0; i < LB; i++) rb[i] = *(const uint4*)(Bg + (size_t)(32 * i) * K);
#pragma unroll
    for (int i = 0; i < LA; i++) *(uint4*)(smem + swz(lrow + 32 * i, lch)) = ra[i];
#pragma unroll
    for (int i = 0; i < LB; i++) *(uint4*)(smem + 16384 + swz(lrow + 32 * i, lch)) = rb[i];
    __syncthreads();
    for (int kt = 0; kt < KT; kt++) {
      const char* sA = smem + (kt & 1) * 32768;
      const char* sB = sA + 16384;
      if (kt + 1 < KT) {
#pragma unroll
        for (int i = 0; i < LA; i++) ra[i] = *(const uint4*)(Ag + (size_t)(32 * i) * K + (kt + 1) * 64);
#pragma unroll
        for (int i = 0; i < LB; i++) rb[i] = *(const uint4*)(Bg + (size_t)(32 * i) * K + (kt + 1) * 64);
      }
#pragma unroll
      for (int kk = 0; kk < 4; kk++) {
        bf16x8 a[MI], b[NI];
        const int ch = kk * 2 + lh;
#pragma unroll
        for (int mi = 0; mi < MI; mi++) a[mi] = *(const bf16x8*)(sA + swz((wm * MI + mi) * 32 + lr, ch));
#pragma unroll
        for (int ni = 0; ni < NI; ni++) b[ni] = *(const bf16x8*)(sB + swz((wn * NI + ni) * 32 + lr, ch));
#pragma unroll
        for (int mi = 0; mi < MI; mi++)
#pragma unroll
          for (int ni = 0; ni < NI; ni++) acc[mi][ni] = MFMA32(a[mi], b[ni], acc[mi][ni]);
      }
      if (kt + 1 < KT) {
        char* dA = smem + ((kt + 1) & 1) * 32768;
#pragma unroll
        for (int i = 0; i < LA; i++) *(uint4*)(dA + swz(lrow + 32 * i, lch)) = ra[i];
#pragma unroll
        for (int i = 0; i < LB; i++) *(uint4*)(dA + 16384 + swz(lrow + 32 * i, lch)) = rb[i];
      }
      __syncthreads();
    }
    epi(acc, mt * BM + wm * MI * 32, nt * BN + wn * NI * 32, lr, lh);
  }
}

#define WAIT_V0() asm volatile("s_waitcnt vmcnt(0)" ::: "memory")
template <int MI, int NI, int WM, int WN, class Epi>
__device__ void gemm_glds(const u16* __restrict__ A, const u16* __restrict__ Bt, int M, int N, int K, const Epi& epi,
                          int bid, int nblk, char* smem, int gap_at = 1 << 30, int gap = 0, bool pair = false) {
  constexpr int BM = 32 * MI * WM, BN = 32 * NI * WN, LA = BM / 32, LB = BN / 32;
  static_assert(WM * WN == 4 && BM <= 128 && BN <= 128, "tile");
  const int tid = opaque_tid(), lane = tid & 63, wv = tid >> 6, wm = wv / WN, wn = wv % WN;
  const int tm = M / BM, tn = N / BN - gap, KT = K >> 6;
  const int lr = lane & 31, lh = lane >> 5;
  const int srow = lane >> 3, pch = lane & 7;
  for (int it = bid; it < tm * tn; it += nblk) {
    int mt, nt;
    const int rnd = it / nblk;
    if (pair && (tn & 1) == 0) {
      int q = it;
      if ((nblk & 15) == 0 && (rnd + 1) * nblk <= tm * tn) {
        const int b0 = it - rnd * nblk;
        q = ((((b0 >> 4) << 3) + (b0 & 7)) << 1) + ((b0 >> 3) & 1) + rnd * nblk;
      }
      mt = (q >> 1) % tm; nt = ((q >> 1) / tm) * 2 + (q & 1);
    } else { mt = it % tm; nt = it / tm; }
    nt += (nt >= gap_at ? gap : 0);
    const u16* Ab = A + (size_t)(mt * BM) * K;
    const u16* Bb = Bt + (size_t)(nt * BN) * K;
    f32x16 acc[MI][NI];
#pragma unroll
    for (int mi = 0; mi < MI; mi++)
#pragma unroll
      for (int ni = 0; ni < NI; ni++)
#pragma unroll
        for (int r = 0; r < 16; r++) acc[mi][ni][r] = 0.f;
#define GLDS_STAGE(buf, kt)                                                                                              \
  do {                                                                                                                   \
    _Pragma("unroll") for (int i = 0; i < LA; i++) {                                                                     \
      const int u_ = wv + 4 * i, row_ = 8 * u_ + srow, c_ = pch ^ ((row_ >> 1) & 7);                                      \
      __builtin_amdgcn_global_load_lds((const unsigned*)(Ab + (size_t)row_ * K + (kt) * 64 + c_ * 8),                    \
                                       (unsigned*)(smem + (buf) * 32768 + u_ * 1024), 16, 0, 0);                         \
    }                                                                                                                    \
    _Pragma("unroll") for (int i = 0; i < LB; i++) {                                                                     \
      const int u_ = wv + 4 * i, row_ = 8 * u_ + srow, c_ = pch ^ ((row_ >> 1) & 7);                                      \
      __builtin_amdgcn_global_load_lds((const unsigned*)(Bb + (size_t)row_ * K + (kt) * 64 + c_ * 8),                    \
                                       (unsigned*)(smem + (buf) * 32768 + 16384 + u_ * 1024), 16, 0, 0);                 \
    }                                                                                                                    \
  } while (0)
    GLDS_STAGE(0, 0);
    WAIT_V0();
    __syncthreads();
    for (int kt = 0; kt < KT; kt++) {
      const char* sA = smem + (kt & 1) * 32768;
      const char* sB = sA + 16384;
      if (kt + 1 < KT) GLDS_STAGE((kt + 1) & 1, kt + 1);
#pragma unroll
      for (int kk = 0; kk < 4; kk++) {
        bf16x8 a[MI], b[NI];
        const int ch = kk * 2 + lh;
#pragma unroll
        for (int mi = 0; mi < MI; mi++) a[mi] = *(const bf16x8*)(sA + swz((wm * MI + mi) * 32 + lr, ch));
#pragma unroll
        for (int ni = 0; ni < NI; ni++) b[ni] = *(const bf16x8*)(sB + swz((wn * NI + ni) * 32 + lr, ch));
        __builtin_amdgcn_s_setprio(1);
#pragma unroll
        for (int mi = 0; mi < MI; mi++)
#pragma unroll
          for (int ni = 0; ni < NI; ni++) acc[mi][ni] = MFMA32(a[mi], b[ni], acc[mi][ni]);
        __builtin_amdgcn_s_setprio(0);
      }
      WAIT_V0();
      __syncthreads();
    }
#undef GLDS_STAGE
    epi(acc, mt * BM + wm * MI * 32, nt * BN + wn * NI * 32, lr, lh);
  }
}

using f32x4 = __attribute__((ext_vector_type(4))) float;
template <int MT, int NT, int WM, int WN, class Epi>
__device__ void gemm_glds16(const u16* __restrict__ A, const u16* __restrict__ Bt, int M, int N, int K, const Epi& epi,
                          int bid, int nblk, char* smem, int gap_at = 1 << 30, int gap = 0, bool pair = false) {
  constexpr int BM = 16 * MT * WM, BN = 16 * NT * WN, LA = BM / 32, LB = BN / 32;
  static_assert(WM * WN == 4 && BM <= 128 && BN <= 128, "tile");
  const int tid = opaque_tid(), lane = tid & 63, wv = tid >> 6, wm = wv / WN, wn = wv % WN;
  const int tm = M / BM, tn = N / BN - gap, KT = K >> 6;
  const int r16 = lane & 15, quad = lane >> 4;
  const int srow = lane >> 3, pch = lane & 7;
  for (int it = bid; it < tm * tn; it += nblk) {
    int mt, nt;
    const int rnd = it / nblk;
    if (pair && (tn & 1) == 0) {
      int q = it;
      if ((nblk & 15) == 0 && (rnd + 1) * nblk <= tm * tn) {
        const int b0 = it - rnd * nblk;
        q = ((((b0 >> 4) << 3) + (b0 & 7)) << 1) + ((b0 >> 3) & 1) + rnd * nblk;
      }
      mt = (q >> 1) % tm; nt = ((q >> 1) / tm) * 2 + (q & 1);
    } else { mt = it % tm; nt = it / tm; }
    nt += (nt >= gap_at ? gap : 0);
    const u16* Ab = A + (size_t)(mt * BM) * K;
    const u16* Bb = Bt + (size_t)(nt * BN) * K;
    f32x4 acc[MT][NT];
#pragma unroll
    for (int mi = 0; mi < MT; mi++)
#pragma unroll
      for (int ni = 0; ni < NT; ni++)
#pragma unroll
        for (int r = 0; r < 4; r++) acc[mi][ni][r] = 0.f;
#define GLDS_STAGE(buf, kt)                                                                                              \
  do {                                                                                                                   \
    _Pragma("unroll") for (int i = 0; i < LA; i++) {                                                                     \
      const int u_ = wv + 4 * i, row_ = 8 * u_ + srow, c_ = pch ^ ((row_ >> 1) & 7);                                      \
      __builtin_amdgcn_global_load_lds((const unsigned*)(Ab + (size_t)row_ * K + (kt) * 64 + c_ * 8),                    \
                                       (unsigned*)(smem + (buf) * 32768 + u_ * 1024), 16, 0, 0);                         \
    }                                                                                                                    \
    _Pragma("unroll") for (int i = 0; i < LB; i++) {                                                                     \
      const int u_ = wv + 4 * i, row_ = 8 * u_ + srow, c_ = pch ^ ((row_ >> 1) & 7);                                      \
      __builtin_amdgcn_global_load_lds((const unsigned*)(Bb + (size_t)row_ * K + (kt) * 64 + c_ * 8),                    \
                                       (unsigned*)(smem + (buf) * 32768 + 16384 + u_ * 1024), 16, 0, 0);                 \
    }                                                                                                                    \
  } while (0)
    GLDS_STAGE(0, 0);
    WAIT_V0();
    __syncthreads();
    for (int kt = 0; kt < KT; kt++) {
      const char* sA = smem + (kt & 1) * 32768;
      const char* sB = sA + 16384;
      if (kt + 1 < KT) GLDS_STAGE((kt + 1) & 1, kt + 1);
      bf16x8 a[2][MT], b[2][NT];
#pragma unroll
      for (int ks = 0; ks < 2; ks++) {
        const int ch = ks * 4 + quad;
#pragma unroll
        for (int mi = 0; mi < MT; mi++) a[ks][mi] = *(const bf16x8*)(sA + swz((wm * MT + mi) * 16 + r16, ch));
#pragma unroll
        for (int ni = 0; ni < NT; ni++) b[ks][ni] = *(const bf16x8*)(sB + swz((wn * NT + ni) * 16 + r16, ch));
      }
      __builtin_amdgcn_sched_barrier(0);
#pragma unroll
      for (int ks = 0; ks < 2; ks++) {
        __builtin_amdgcn_s_setprio(1);
#pragma unroll
        for (int mi = 0; mi < MT; mi++)
#pragma unroll
          for (int ni = 0; ni < NT; ni++) acc[mi][ni] = __builtin_amdgcn_mfma_f32_16x16x32_bf16(a[ks][mi], b[ks][ni], acc[mi][ni], 0, 0, 0);
        __builtin_amdgcn_s_setprio(0);
      }
      WAIT_V0();
      __syncthreads();
    }
#undef GLDS_STAGE
    {
      int er = mt * BM + wm * MT * 16, ec = nt * BN + wn * NT * 16, e16 = r16, eq = quad;
      asm volatile("" : "+v"(er), "+v"(ec), "+v"(e16), "+v"(eq));
      epi(acc, __builtin_amdgcn_readfirstlane(er), __builtin_amdgcn_readfirstlane(ec), e16, eq);
    }
  }
}

using u32x4 = __attribute__((ext_vector_type(4))) unsigned;
__device__ __forceinline__ bf16x8 pack8(float a, float b, float c, float d, float e, float f, float g, float h) {
  u32x4 u; u[0] = pack2(a, b); u[1] = pack2(c, d); u[2] = pack2(e, f); u[3] = pack2(g, h);
  return __builtin_bit_cast(bf16x8, u);
}
#define PACKX(X, s) pack8(X[8 * (s)], X[8 * (s) + 1], X[8 * (s) + 2], X[8 * (s) + 3], X[8 * (s) + 4], X[8 * (s) + 5], X[8 * (s) + 6], X[8 * (s) + 7])

__device__ __forceinline__ void gla_geom(int it, int& h, int& T, int& tok0, int& s0) {
  h = it & 7;
  int ci = it >> 3;
  if (ci < 64) { T = 256; tok0 = (ci >> 2) * 256; s0 = (ci & 3) * 64; }
  else { int u = ci - 64; T = 1024; tok0 = NCTX + (u >> 4) * 1024; s0 = (u & 15) * 64; }
}

__device__ __forceinline__ void gla_gate_prefix(int dir, const float* wsm, float2 bb, const float* lrs, float* Bs, float* tot) {
  const int tid = opaque_tid(), dp = tid & 31, seg = tid >> 5, d0 = dp * 2;
  float w0[16], w1[16];
#pragma unroll
  for (int r = 0; r < 16; r++) { float2 v = *(const float2*)(wsm + dir * 1024 + r * 64 + d0); w0[r] = v.x; w1[r] = v.y; }
  float run0 = 0.f, run1 = 0.f;
#pragma unroll
  for (int i = 0; i < 8; i++) {
    const int j = seg * 8 + i;
    const float* l = lrs + j * 32 + dir * 16;
    float x0 = bb.x, x1 = bb.y;
#pragma unroll
    for (int r = 0; r < 16; r++) { float lv = l[r]; x0 += lv * w0[r]; x1 += lv * w1[r]; }
    run0 += logsig_f(x0) * (1.f / 16.f);
    run1 += logsig_f(x1) * (1.f / 16.f);
    *(float2*)(Bs + j * 64 + d0) = make_float2(run0, run1);
  }
  *(float2*)(tot + seg * 64 + d0) = make_float2(run0, run1);
  __syncthreads();
  float o0 = 0.f, o1 = 0.f;
  for (int s2 = 0; s2 < seg; s2++) { o0 += tot[s2 * 64 + d0]; o1 += tot[s2 * 64 + d0 + 1]; }
#pragma unroll
  for (int i = 0; i < 8; i++) {
    const int j = seg * 8 + i;
    float2 v = *(float2*)(Bs + j * 64 + d0);
    v.x += o0; v.y += o1;
    *(float2*)(Bs + j * 64 + d0) = v;
  }
  __syncthreads();
}

__device__ void gla_pass1_item(const P& p, int it, char* smem) {
  int h, T, tok0, s0;
  gla_geom(it, h, T, tok0, s0);
  const int t0 = tok0 + s0;
  float* lrs = (float*)smem; float* Bs = (float*)(smem + 8192); float* tot = (float*)(smem + 24576);
  char* KhT = smem + 26624;
  const int tid = opaque_tid(), lane = tid & 63, wv = tid >> 6, wr = wv >> 1, wc = wv & 1, r = lane & 31, hh = lane >> 5;
  const int dp = tid & 31, seg = tid >> 5, d0 = dp * 2;
#pragma unroll
  for (int i = 0; i < 2; i++) { int idx = tid + 256 * i; ((float4*)lrs)[idx] = ((const float4*)(p.lr + (size_t)t0 * 32))[idx]; }
  float* wsm = (float*)(smem + 36864);
#pragma unroll
  for (int i = 0; i < 2; i++) {
    const int idx = tid + 256 * i, wd = idx >> 8, wr_ = (idx >> 4) & 15, c4 = (idx & 15) * 4;
    ((float4*)wsm)[idx] = *(const float4*)((wd ? p.wgb : p.wgf) + wr_ * 512 + h * 64 + c4);
  }
  const float2 bbf = *(const float2*)(p.bgf + h * 64 + d0), bbb = *(const float2*)(p.bgb + h * 64 + d0);
  bf16x8 vf[4];
#pragma unroll
  for (int ks = 0; ks < 4; ks++)
    vf[ks] = *(const bf16x8*)(p.gvT + (size_t)tok0 * 512 + (size_t)(h * 64 + 32 * wc + r) * T + s0 + ks * 16 + 8 * hh);
  unsigned kk[8];
#pragma unroll
  for (int i = 0; i < 8; i++) kk[i] = *(const unsigned*)(p.gk + (size_t)(t0 + seg * 8 + i) * 512 + h * 64 + d0);
  __syncthreads();
#pragma unroll
  for (int dir = 0; dir < 2; dir++) {
    gla_gate_prefix(dir, wsm, dir ? bbb : bbf, lrs, Bs, tot);
    {
      float4* bd = (float4*)(p.Bst + ((size_t)it * 2 + dir) * 4096);
#pragma unroll
      for (int i = 0; i < 4; i++) bd[tid + 256 * i] = ((const float4*)Bs)[tid + 256 * i];
    }
    float v0[8], v1[8];
    const float tl0 = Bs[63 * 64 + d0], tl1 = Bs[63 * 64 + d0 + 1];
#pragma unroll
    for (int i = 0; i < 8; i++) {
      const int j = seg * 8 + i;
      float f0, f1;
      if (dir == 0) { f0 = __expf(tl0 - Bs[j * 64 + d0]); f1 = __expf(tl1 - Bs[j * 64 + d0 + 1]); }
      else { f0 = j > 0 ? __expf(Bs[(j - 1) * 64 + d0]) : 1.f; f1 = j > 0 ? __expf(Bs[(j - 1) * 64 + d0 + 1]) : 1.f; }
      v0[i] = bflo(kk[i]) * f0;
      v1[i] = bfhi(kk[i]) * f1;
    }
    *(bf16x8*)(KhT + swz(d0, seg)) = pack8(v0[0], v0[1], v0[2], v0[3], v0[4], v0[5], v0[6], v0[7]);
    *(bf16x8*)(KhT + swz(d0 + 1, seg)) = pack8(v1[0], v1[1], v1[2], v1[3], v1[4], v1[5], v1[6], v1[7]);
    if (seg == 7) *(float2*)(p.dec + ((size_t)it * 2 + dir) * 64 + d0) = make_float2(__expf(tl0), __expf(tl1));
    __syncthreads();
    f32x16 acc;
#pragma unroll
    for (int q = 0; q < 16; q++) acc[q] = 0.f;
#pragma unroll
    for (int ks = 0; ks < 4; ks++) {
      bf16x8 a = *(const bf16x8*)(KhT + swz(32 * wr + r, ks * 2 + hh));
      acc = MFMA32(a, vf[ks], acc);
    }
    float* dst = p.dS + ((size_t)it * 2 + dir) * 4096 + (32 * wc + r) * 64 + 32 * wr + 4 * hh;
#pragma unroll
    for (int g = 0; g < 4; g++) *(float4*)(dst + 8 * g) = make_float4(acc[4 * g], acc[4 * g + 1], acc[4 * g + 2], acc[4 * g + 3]);
    __syncthreads();
  }
}

__device__ void gla_scan_item(const P& p, int it) {
  const int part = it & 3, dir = (it >> 2) & 1, h = (it >> 3) & 7, seq = it >> 6;
  const int n = seq < 16 ? 4 : 16;
  const int cibase = seq < 16 ? seq * 4 : 64 + (seq - 16) * 16;
  const int idx = part * 1024 + threadIdx.x * 4, e = idx >> 6, d = idx & 63;
  float4 S = make_float4(0.f, 0.f, 0.f, 0.f);
  if (seq >= 16) {
    const float* s0 = (dir ? p.sgb : p.sgf) + (size_t)((seq - 16) * 8 + h) * 4096;
    S = make_float4(s0[d * 64 + e], s0[(d + 1) * 64 + e], s0[(d + 2) * 64 + e], s0[(d + 3) * 64 + e]);
  }
  for (int k = 0; k < n; k++) {
    const int c = dir ? n - 1 - k : k;
    const size_t item = ((size_t)(cibase + c) * 8 + h) * 2 + dir;
    float4* ptr = (float4*)(p.dS + item * 4096 + idx);
    const float4 dv = *ptr;
    const float4 dc = *(const float4*)(p.dec + item * 64 + d);
    *ptr = S;
    S.x = dc.x * S.x + dv.x; S.y = dc.y * S.y + dv.y; S.z = dc.z * S.z + dv.z; S.w = dc.w * S.w + dv.w;
  }
  if (seq < 16) {
    float* so = p.out + (dir ? 7864320 : 7340032) + (size_t)(seq * 8 + h) * 4096;
    so[d * 64 + e] = S.x; so[(d + 1) * 64 + e] = S.y; so[(d + 2) * 64 + e] = S.z; so[(d + 3) * 64 + e] = S.w;
  }
}

__device__ void gla_pass2_item(const P& p, int it, char* smem) {
  int h, T, tok0, s0;
  gla_geom(it, h, T, tok0, s0);
  const int t0 = tok0 + s0;
  float* red = (float*)smem;
  const int tid = opaque_tid(), lane = tid & 63, wv = tid >> 6, wr = wv >> 1, wc = wv & 1, r = lane & 31, hh = lane >> 5;
  const int dp = tid & 31, seg = tid >> 5, d0 = dp * 2;
  unsigned qq[8], kk[8];
#pragma unroll
  for (int i = 0; i < 8; i++) {
    qq[i] = *(const unsigned*)(p.gq + (size_t)(t0 + seg * 8 + i) * 512 + h * 64 + d0);
    kk[i] = *(const unsigned*)(p.gk + (size_t)(t0 + seg * 8 + i) * 512 + h * 64 + d0);
  }
  bf16x8 vf[2][2];
#pragma unroll
  for (int jt = 0; jt < 2; jt++)
#pragma unroll
    for (int s = 0; s < 2; s++) {
      const u16* base = p.gvT + (size_t)tok0 * 512 + (size_t)(h * 64 + 32 * wc + r) * T + s0 + 32 * jt + 16 * s + 4 * hh;
      uint2 lo = *(const uint2*)base, hi = *(const uint2*)(base + 8);
      u32x4 u; u[0] = lo.x; u[1] = lo.y; u[2] = hi.x; u[3] = hi.y;
      vf[jt][s] = __builtin_bit_cast(bf16x8, u);
    }
  float4 sp[2][8];
#pragma unroll
  for (int dir = 0; dir < 2; dir++) {
    const float* Sp = p.dS + ((size_t)it * 2 + dir) * 4096 + (32 * wc + r) * 64 + 8 * hh;
#pragma unroll
    for (int ks = 0; ks < 4; ks++) { sp[dir][2 * ks] = *(const float4*)(Sp + ks * 16); sp[dir][2 * ks + 1] = *(const float4*)(Sp + ks * 16 + 4); }
  }
  {
    const float4* bsrc = (const float4*)(p.Bst + (size_t)it * 2 * 4096);
    float4 tmp[8];
#pragma unroll
    for (int i = 0; i < 8; i++) tmp[i] = bsrc[tid + 256 * i];
#pragma unroll
    for (int i = 0; i < 8; i++) ((float4*)smem)[tid + 256 * i] = tmp[i];
  }
  __syncthreads();
#pragma unroll
  for (int dir = 0; dir < 2; dir++) {
    const float* Bs = (const float*)(smem + dir * 16384);
    char* Qt = smem + (dir ? 49152 : 32768);
    char* Kt = smem + (dir ? 57344 : 40960);
    const float tl0 = Bs[63 * 64 + d0], tl1 = Bs[63 * 64 + d0 + 1];
#pragma unroll
    for (int i = 0; i < 8; i++) {
      const int j = seg * 8 + i;
      float b0, b1;
      if (dir == 0) { b0 = Bs[j * 64 + d0]; b1 = Bs[j * 64 + d0 + 1]; }
      else {
        float p0 = j > 0 ? Bs[(j - 1) * 64 + d0] : 0.f, p1 = j > 0 ? Bs[(j - 1) * 64 + d0 + 1] : 0.f;
        b0 = tl0 - p0; b1 = tl1 - p1;
      }
      const float eq0 = __expf(b0), eq1 = __expf(b1), ek0 = __expf(-b0), ek1 = __expf(-b1);
      const int off = swz(j, dp >> 2) + (dp & 3) * 4;
      *(unsigned*)(Qt + off) = pack2(bflo(qq[i]) * eq0, bfhi(qq[i]) * eq1);
      *(unsigned*)(Kt + off) = pack2(bflo(kk[i]) * ek0, bfhi(kk[i]) * ek1);
    }
    __syncthreads();
  }
  f32x16 O;
#pragma unroll
  for (int q = 0; q < 16; q++) O[q] = 0.f;
#pragma unroll
  for (int dir = 0; dir < 2; dir++) {
    const char* Qt = smem + (dir ? 49152 : 32768);
    const char* Kt = smem + (dir ? 57344 : 40960);
    bf16x8 qf[4];
#pragma unroll
    for (int ks = 0; ks < 4; ks++) qf[ks] = *(const bf16x8*)(Qt + swz(32 * wr + r, ks * 2 + hh));
#pragma unroll
    for (int jt = 0; jt < 2; jt++) {
      const bool use = dir == 0 ? (jt <= wr) : (jt >= wr);
      if (use) {
        f32x16 X;
#pragma unroll
        for (int q = 0; q < 16; q++) X[q] = 0.f;
#pragma unroll
        for (int ks = 0; ks < 4; ks++) {
          bf16x8 a = *(const bf16x8*)(Kt + swz(32 * jt + r, ks * 2 + hh));
          X = MFMA32(a, qf[ks], X);
        }
        if (jt == wr) {
#pragma unroll
          for (int q = 0; q < 16; q++) {
            const int jl = crow(q, hh);
            const bool keep = dir == 0 ? (jl <= r) : (jl >= r);
            X[q] = keep ? X[q] : 0.f;
          }
        }
        O = MFMA32(vf[jt][0], PACKX(X, 0), O);
        O = MFMA32(vf[jt][1], PACKX(X, 1), O);
      }
    }
#pragma unroll
    for (int ks = 0; ks < 4; ks++) {
      const float4 a0 = sp[dir][2 * ks], a1 = sp[dir][2 * ks + 1];
      bf16x8 sa = pack8(a0.x, a0.y, a0.z, a0.w, a1.x, a1.y, a1.z, a1.w);
      O = MFMA32(sa, qf[ks], O);
    }
  }
  float ss = 0.f;
#pragma unroll
  for (int q = 0; q < 16; q++) ss += O[q] * O[q];
  ss += __shfl_xor(ss, 32);
  if (hh == 0) red[wc * 64 + 32 * wr + r] = ss;
  __syncthreads();
  const float rstd = rsqrtf((red[32 * wr + r] + red[64 + 32 * wr + r]) * (1.f / 64.f) + 1e-6f);
  const int t = t0 + 32 * wr + r;
#pragma unroll
  for (int g = 0; g < 4; g++) {
    const int e0 = 32 * wc + 8 * g + 4 * hh;
    const uint2 gv = *(const uint2*)(p.gg + (size_t)t * 512 + h * 64 + e0);
    const float4 gn = *(const float4*)(p.gla_norm + e0);
    float o0 = O[4 * g] * rstd * gn.x * silu_f(bflo(gv.x));
    float o1 = O[4 * g + 1] * rstd * gn.y * silu_f(bfhi(gv.x));
    float o2 = O[4 * g + 2] * rstd * gn.z * silu_f(bflo(gv.y));
    float o3 = O[4 * g + 3] * rstd * gn.w * silu_f(bfhi(gv.y));
    uint2 o; o.x = pack2(o0, o1); o.y = pack2(o2, o3);
    *(uint2*)(p.act + (size_t)t * DM + h * 64 + e0) = o;
  }
  __syncthreads();
}

#define N_ATT_ITEMS 384
__device__ void attn_item(const P& p, int it, char* smem) {
  const bool lat = it < 128;
  int b, kvh, qb, T, tok0, nloc, ntile;
  if (lat) { b = it >> 6; kvh = (it >> 5) & 1; qb = it & 31; T = 1024; tok0 = NCTX + b * 1024; nloc = 5; ntile = 13; }
  else { int u = it - 128; b = u >> 4; kvh = (u >> 3) & 1; qb = u & 7; T = 256; tok0 = b * 256; nloc = 4; ntile = 4; }
  const int q0 = qb * 32, kstart = lat ? q0 - 128 : 0;
  const int tid = opaque_tid(), lane = tid & 63, wv = tid >> 6, r = lane & 31, hh = lane >> 5;
  const int hd = kvh * 4 + wv;
  const int lrow = tid >> 3, lch = tid & 7;
  bf16x8 qf[4];
#pragma unroll
  for (int ks = 0; ks < 4; ks++) qf[ks] = *(const bf16x8*)(p.sq + (size_t)(tok0 + q0 + r) * 512 + hd * 64 + ks * 16 + 8 * hh);
  float m = p.sink[hd] * 1.44269504088896f;
  float l = hh == 0 ? 1.f : 0.f;
  const int klo = max(q0 + r - 128, 0);
  const unsigned kspan = (unsigned)(min(q0 + r + 128, T - 1) - klo);
  f32x16 ZERO16 = {0.f, 0.f, 0.f, 0.f, 0.f, 0.f, 0.f, 0.f, 0.f, 0.f, 0.f, 0.f, 0.f, 0.f, 0.f, 0.f};
  asm volatile("" : "+v"(ZERO16));
  f32x16 O[2];
#pragma unroll
  for (int q = 0; q < 16; q++) { O[0][q] = 0.f; O[1][q] = 0.f; }
  uint4 rk0, rk1, rv0, rv1;
#define ATT_LOAD(tt)                                                                                                    \
  do {                                                                                                                  \
    if ((tt) < nloc) {                                                                                                  \
      const int kb_ = kstart + (tt) * 64;                                                                               \
      const int k0_ = min(max(kb_ + lrow, 0), T - 1), k1_ = min(max(kb_ + lrow + 32, 0), T - 1);                         \
      rk0 = *(const uint4*)(p.sk + (size_t)(tok0 + k0_) * 128 + kvh * 64 + lch * 8);                                    \
      rk1 = *(const uint4*)(p.sk + (size_t)(tok0 + k1_) * 128 + kvh * 64 + lch * 8);                                    \
      const int kv0_ = kb_ + lch * 8;                                                                                   \
      rv0 = make_uint4(0u, 0u, 0u, 0u); rv1 = rv0;                                                                      \
      if (kv0_ >= 0 && kv0_ < T) {                                                                                      \
        rv0 = *(const uint4*)(p.svT + (size_t)tok0 * 128 + (size_t)(kvh * 64 + lrow) * T + kv0_);                       \
        rv1 = *(const uint4*)(p.svT + (size_t)tok0 * 128 + (size_t)(kvh * 64 + lrow + 32) * T + kv0_);                  \
      }                                                                                                                 \
    } else {                                                                                                            \
      const int kb_ = ((tt) - nloc) * 64;                                                                               \
      rk0 = *(const uint4*)(p.ckb + ((size_t)(b * 2 + kvh) * 512 + kb_ + lrow) * 64 + lch * 8);                         \
      rk1 = *(const uint4*)(p.ckb + ((size_t)(b * 2 + kvh) * 512 + kb_ + lrow + 32) * 64 + lch * 8);                    \
      rv0 = *(const uint4*)(p.cvT + ((size_t)(b * 2 + kvh) * 64 + lrow) * 512 + kb_ + lch * 8);                         \
      rv1 = *(const uint4*)(p.cvT + ((size_t)(b * 2 + kvh) * 64 + lrow + 32) * 512 + kb_ + lch * 8);                    \
    }                                                                                                                   \
  } while (0)
#define ATT_STORE(buf)                                                                                                  \
  do {                                                                                                                  \
    char* sK_ = smem + (buf) * 16384;                                                                                   \
    const int o0_ = swz(lrow, lch), o1_ = swz(lrow + 32, lch);                                                          \
    *(uint4*)(sK_ + o0_) = rk0; *(uint4*)(sK_ + o1_) = rk1;                                                             \
    *(uint4*)(sK_ + 8192 + o0_) = rv0; *(uint4*)(sK_ + 8192 + o1_) = rv1;                                               \
  } while (0)
  ATT_LOAD(0);
  ATT_STORE(0);
  __syncthreads();
  for (int tt = 0; tt < ntile; tt++) {
    const char* sK = smem + (tt & 1) * 16384;
    const char* sV = sK + 8192;
    if (tt + 1 < ntile) ATT_LOAD(tt + 1);
    f32x16 X[2];
#pragma unroll
    for (int sub = 0; sub < 2; sub++) {
      X[sub] = MFMA32(*(const bf16x8*)(sK + swz(32 * sub + r, hh)), qf[0], ZERO16);
#pragma unroll
      for (int ks = 1; ks < 4; ks++) {
        bf16x8 a = *(const bf16x8*)(sK + swz(32 * sub + r, ks * 2 + hh));
        X[sub] = MFMA32(a, qf[ks], X[sub]);
      }
    }
    const int kb0 = kstart + tt * 64;
    if (lat && tt < nloc && (kb0 < q0 - 97 || kb0 + 63 > q0 + 128 || kb0 < 0 || kb0 + 63 >= T)) {
      const int base = kb0 - klo;
#pragma unroll
      for (int sub = 0; sub < 2; sub++)
#pragma unroll
        for (int q = 0; q < 16; q++) {
          const unsigned rel = (unsigned)(base + 32 * sub + crow(q, hh));
          X[sub][q] = rel <= kspan ? X[sub][q] : -1e30f;
        }
    }
    float mx = fmaxf(X[0][0], X[1][0]);
#pragma unroll
    for (int q = 1; q < 16; q++) mx = fmaxf(fmaxf(mx, X[0][q]), X[1][q]);
    mx = fmaxf(mx, __shfl_xor(mx, 32));
    if (__any(mx > m + 8.f)) {
      const float mn = fmaxf(m, mx);
      const float alpha = __builtin_amdgcn_exp2f(m - mn);
      m = mn;
      l *= alpha;
#pragma unroll
      for (int q = 0; q < 16; q++) { O[0][q] *= alpha; O[1][q] *= alpha; }
    }
    float ps = 0.f;
#pragma unroll
    for (int sub = 0; sub < 2; sub++)
#pragma unroll
      for (int q = 0; q < 16; q++) {
        float pv = __builtin_amdgcn_exp2f(X[sub][q] - m);
        X[sub][q] = pv;
        ps += pv;
      }
    l += ps;
#pragma unroll
    for (int sub = 0; sub < 2; sub++)
#pragma unroll
      for (int s = 0; s < 2; s++) {
        const bf16x8 pb = s == 0 ? PACKX(X[sub], 0) : PACKX(X[sub], 1);
#pragma unroll
        for (int dt = 0; dt < 2; dt++) {
          const int row = 32 * dt + r;
          const int ch = 4 * sub + 2 * s;
          uint2 lo = *(const uint2*)(sV + swz(row, ch) + 8 * hh);
          uint2 hi = *(const uint2*)(sV + swz(row, ch + 1) + 8 * hh);
          u32x4 u; u[0] = lo.x; u[1] = lo.y; u[2] = hi.x; u[3] = hi.y;
          O[dt] = MFMA32(__builtin_bit_cast(bf16x8, u), pb, O[dt]);
        }
      }
    if (tt + 1 < ntile) ATT_STORE((tt + 1) & 1);
    __syncthreads();
  }
  l += __shfl_xor(l, 32);
  const float inv = 1.f / l;
  const int t = tok0 + q0 + r;
#pragma unroll
  for (int dt = 0; dt < 2; dt++)
#pragma unroll
    for (int g = 0; g < 4; g++) {
      const int dd = 32 * dt + 8 * g + 4 * hh;
      uint2 o;
      o.x = pack2(O[dt][4 * g] * inv, O[dt][4 * g + 1] * inv);
      o.y = pack2(O[dt][4 * g + 2] * inv, O[dt][4 * g + 3] * inv);
      *(uint2*)(p.act + (size_t)t * DM + 512 + hd * 64 + dd) = o;
    }
}

#define SCQ (0.125f * 1.44269504088896f)
struct EpiProj {
  const P& p;
  __device__ __forceinline__ void operator()(f32x16 (&acc)[2][2], int rb, int cb, int lr, int lh) const {
    const int n64 = cb >> 6;
    int tok0, T, s0;
    tok_seq(rb, tok0, T, s0);
    const bool lat = rb >= NCTX;
    if (n64 < 16 || (n64 >= 24 && n64 < 32)) {
      u16* dst = n64 < 8 ? p.gq : (n64 < 16 ? p.gk : p.gg);
      const float sc = n64 < 8 ? 0.125f : 1.f;
      const int c = (n64 & 7) * 64 + lr;
#pragma unroll
      for (int mi = 0; mi < 2; mi++)
#pragma unroll
        for (int ni = 0; ni < 2; ni++)
#pragma unroll
          for (int q = 0; q < 16; q++)
            dst[(size_t)(rb + mi * 32 + crow(q, lh)) * 512 + c + ni * 32] = f2bf(acc[mi][ni][q] * sc);
    } else if (n64 < 24) {
      const int h = n64 - 16;
#pragma unroll
      for (int mi = 0; mi < 2; mi++)
#pragma unroll
        for (int ni = 0; ni < 2; ni++) {
          u16* dst = p.gvT + (size_t)tok0 * 512 + (size_t)(h * 64 + ni * 32 + lr) * T + s0 + mi * 32 + 4 * lh;
#pragma unroll
          for (int g = 0; g < 4; g++) {
            uint2 o;
            o.x = pack2(acc[mi][ni][4 * g], acc[mi][ni][4 * g + 1]);
            o.y = pack2(acc[mi][ni][4 * g + 2], acc[mi][ni][4 * g + 3]);
            *(uint2*)(dst + 8 * g) = o;
          }
        }
    } else if (n64 < 42) {
      const bool isq = n64 < 40;
      const float* gain = isq ? p.q_norm : p.k_norm;
      const float g0 = gain[lr], g1 = gain[32 + lr];
      const int hb = isq ? (n64 - 32) * 64 : (n64 - 40) * 64;
#pragma unroll
      for (int mi = 0; mi < 2; mi++)
#pragma unroll
        for (int q = 0; q < 16; q++) {
          float v0 = acc[mi][0][q], v1 = acc[mi][1][q];
          float ss = v0 * v0 + v1 * v1;
          ss += __shfl_xor(ss, 1); ss += __shfl_xor(ss, 2); ss += __shfl_xor(ss, 4); ss += __shfl_xor(ss, 8); ss += __shfl_xor(ss, 16);
          const float rstd = rsqrtf(ss * (1.f / 64.f) + 1e-6f);
          v0 *= rstd * g0; v1 *= rstd * g1;
          const int s = s0 + mi * 32 + crow(q, lh);
          const int t = rb + mi * 32 + crow(q, lh);
          if (lat) {
            const float pa0 = __shfl_xor(v0, 16), pa1 = __shfl_xor(v1, 16);
            const float2 c0 = p.rope[(s >> 6) * 16 + (lr & 15)], c1 = p.rope[(s & 63) * 16 + (lr & 15)];
            v0 = (lr & 16) ? (v0 * c0.x + pa0 * c0.y) : (v0 * c0.x - pa0 * c0.y);
            v1 = (lr & 16) ? (v1 * c1.x + pa1 * c1.y) : (v1 * c1.x - pa1 * c1.y);
          }
          if (isq) {
            p.sq[(size_t)t * 512 + hb + lr] = f2bf(v0 * SCQ);
            p.sq[(size_t)t * 512 + hb + 32 + lr] = f2bf(v1 * SCQ);
          } else {
            p.sk[(size_t)t * 128 + hb + lr] = f2bf(v0);
            p.sk[(size_t)t * 128 + hb + 32 + lr] = f2bf(v1);
            if (!lat) {
              float* o = p.out + 6291456 + ((size_t)((rb >> 8) * 2 + (n64 - 40)) * 256 + s) * 64;
              o[lr] = v0; o[32 + lr] = v1;
            }
          }
        }
    } else if (n64 < 44) {
      const int kvh = n64 - 42;
#pragma unroll
      for (int mi = 0; mi < 2; mi++)
#pragma unroll
        for (int ni = 0; ni < 2; ni++) {
          u16* dst = p.svT + (size_t)tok0 * 128 + (size_t)(kvh * 64 + ni * 32 + lr) * T + s0 + mi * 32 + 4 * lh;
#pragma unroll
          for (int g = 0; g < 4; g++) {
            uint2 o;
            o.x = pack2(acc[mi][ni][4 * g], acc[mi][ni][4 * g + 1]);
            o.y = pack2(acc[mi][ni][4 * g + 2], acc[mi][ni][4 * g + 3]);
            *(uint2*)(dst + 8 * g) = o;
          }
          if (!lat) {
#pragma unroll
            for (int q = 0; q < 16; q++) {
              const int s = s0 + mi * 32 + crow(q, lh);
              p.out[6815744 + ((size_t)((rb >> 8) * 2 + kvh) * 256 + s) * 64 + ni * 32 + lr] = acc[mi][ni][q];
            }
          }
        }
    } else if (n64 == 44) {
#pragma unroll
      for (int mi = 0; mi < 2; mi++)
#pragma unroll
        for (int q = 0; q < 16; q++) p.lr[(size_t)(rb + mi * 32 + crow(q, lh)) * 32 + lr] = acc[mi][0][q];
    }
  }
};
__device__ __forceinline__ void stage_rows16(char* wsm, u16* dst, size_t ld) {
  const int lane = threadIdx.x & 63, r0 = lane >> 3, ch = lane & 7;
  __builtin_amdgcn_wave_barrier();
#pragma unroll
  for (int i = 0; i < 8; i++) {
    const int row = r0 + 8 * i;
    *(uint4*)(dst + (size_t)row * ld + ch * 8) = *(const uint4*)(wsm + row * 144 + ch * 16);
  }
}
struct EpiGG16 {
  u16* gg;
  char* smem;
  __device__ __forceinline__ void operator()(f32x4 (&acc)[4][4], int rb, int cb, int r16, int quad) const {
    char* wsm = smem + (threadIdx.x >> 6) * 9216;
#pragma unroll
    for (int mi = 0; mi < 4; mi++)
#pragma unroll
      for (int ni = 0; ni < 4; ni++)
#pragma unroll
        for (int j = 0; j < 4; j++) *(u16*)(wsm + (mi * 16 + quad * 4 + j) * 144 + (ni * 16 + r16) * 2) = f2bf(acc[mi][ni][j]);
    stage_rows16(wsm, gg + (size_t)rb * 512 + ((cb >> 6) & 7) * 64, 512);
    __syncthreads();
  }
};
struct EpiProj16 {
  const P& p;
  char* smem;
  __device__ __forceinline__ void operator()(f32x4 (&acc)[4][4], int rb, int cb, int r16, int quad) const {
    const int n64 = cb >> 6;
    int tok0, T, s0;
    tok_seq(rb, tok0, T, s0);
    const bool lat = rb >= NCTX;
    char* wsm = smem + (threadIdx.x >> 6) * 9216;
    if (n64 < 16 || (n64 >= 24 && n64 < 32)) {
      u16* dst = n64 < 8 ? p.gq : (n64 < 16 ? p.gk : p.gg);
      const float sc = n64 < 8 ? 0.125f : 1.f;
#pragma unroll
      for (int mi = 0; mi < 4; mi++)
#pragma unroll
        for (int ni = 0; ni < 4; ni++)
#pragma unroll
          for (int j = 0; j < 4; j++) *(u16*)(wsm + (mi * 16 + quad * 4 + j) * 144 + (ni * 16 + r16) * 2) = f2bf(acc[mi][ni][j] * sc);
      stage_rows16(wsm, dst + (size_t)rb * 512 + (n64 & 7) * 64, 512);
    } else if (n64 < 24 || (n64 >= 42 && n64 < 44)) {
      const bool isg = n64 < 24;
      const int hb = isg ? (n64 - 16) * 64 : (n64 - 42) * 64;
      u16* base = isg ? p.gvT + (size_t)tok0 * 512 : p.svT + (size_t)tok0 * 128;
#pragma unroll
      for (int mi = 0; mi < 4; mi++)
#pragma unroll
        for (int ni = 0; ni < 4; ni++) {
          uint2 o;
          o.x = pack2(acc[mi][ni][0], acc[mi][ni][1]);
          o.y = pack2(acc[mi][ni][2], acc[mi][ni][3]);
          *(uint2*)(base + (size_t)(hb + ni * 16 + r16) * T + s0 + mi * 16 + quad * 4) = o;
          if (!isg && !lat) {
#pragma unroll
            for (int j = 0; j < 4; j++) {
              const int s = s0 + mi * 16 + quad * 4 + j;
              st_nt(p.out + 6815744 + ((size_t)((rb >> 8) * 2 + (n64 - 42)) * 256 + s) * 64 + ni * 16 + r16, acc[mi][ni][j]);
            }
          }
        }
    } else if (n64 < 42) {
      const bool isq = n64 < 40;
      const float* gain = isq ? p.q_norm : p.k_norm;
      float g[4];
#pragma unroll
      for (int ni = 0; ni < 4; ni++) g[ni] = gain[ni * 16 + r16];
#pragma unroll
      for (int mi = 0; mi < 4; mi++)
#pragma unroll
        for (int j = 0; j < 4; j++) {
          float v[4];
          float ss = 0.f;
#pragma unroll
          for (int ni = 0; ni < 4; ni++) { v[ni] = acc[mi][ni][j]; ss += v[ni] * v[ni]; }
          ss += __shfl_xor(ss, 1); ss += __shfl_xor(ss, 2); ss += __shfl_xor(ss, 4); ss += __shfl_xor(ss, 8);
          const float rstd = rsqrtf(ss * (1.f / 64.f) + 1e-6f);
#pragma unroll
          for (int ni = 0; ni < 4; ni++) v[ni] *= rstd * g[ni];
          const int rl = mi * 16 + quad * 4 + j, s = s0 + rl;
          if (lat) {
            const float2 c0 = p.rope[(s >> 6) * 16 + r16], c1 = p.rope[(s & 63) * 16 + r16];
            const float a0 = v[0] * c0.x - v[1] * c0.y, a1 = v[1] * c0.x + v[0] * c0.y;
            const float a2 = v[2] * c1.x - v[3] * c1.y, a3 = v[3] * c1.x + v[2] * c1.y;
            v[0] = a0; v[1] = a1; v[2] = a2; v[3] = a3;
          }
          const float osc = isq ? SCQ : 1.f;
#pragma unroll
          for (int ni = 0; ni < 4; ni++) *(u16*)(wsm + rl * 144 + (ni * 16 + r16) * 2) = f2bf(v[ni] * osc);
          if (!isq && !lat) {
            float* o = p.out + 6291456 + ((size_t)((rb >> 8) * 2 + (n64 - 40)) * 256 + s) * 64 + r16;
#pragma unroll
            for (int ni = 0; ni < 4; ni++) st_nt(o + ni * 16, v[ni]);
          }
          __builtin_amdgcn_sched_barrier(0);
        }
      if (isq) stage_rows16(wsm, p.sq + (size_t)rb * 512 + (n64 - 32) * 64, 512);
      else stage_rows16(wsm, p.sk + (size_t)rb * 128 + (n64 - 40) * 64, 128);
    } else if (n64 == 44) {
#pragma unroll
      for (int mi = 0; mi < 4; mi++)
#pragma unroll
        for (int ni = 0; ni < 2; ni++)
#pragma unroll
          for (int j = 0; j < 4; j++) p.lr[(size_t)(rb + mi * 16 + quad * 4 + j) * 32 + ni * 16 + r16] = acc[mi][ni][j];
    }
    __syncthreads();
  }
};
struct EpiGG {
  u16* gg;
  __device__ __forceinline__ void operator()(f32x16 (&acc)[2][2], int rb, int cb, int lr, int lh) const {
    const int c = ((cb >> 6) & 7) * 64 + lr;
#pragma unroll
    for (int mi = 0; mi < 2; mi++)
#pragma unroll
      for (int ni = 0; ni < 2; ni++)
#pragma unroll
        for (int q = 0; q < 16; q++) gg[(size_t)(rb + mi * 32 + crow(q, lh)) * 512 + c + ni * 32] = f2bf(acc[mi][ni][q]);
  }
};
struct EpiWo {
  const P& p;
  template <int MI, int NI>
  __device__ __forceinline__ void operator()(f32x16 (&acc)[MI][NI], int rb, int cb, int lr, int lh) const {
#pragma unroll
    for (int mi = 0; mi < MI; mi++) {
      const float* md = p.mod + tok_cond(rb + mi * 32) * MODN + 2048 + cb + lr;
#pragma unroll
      for (int ni = 0; ni < NI; ni++) {
        const float g = md[ni * 32];
#pragma unroll
        for (int q = 0; q < 16; q++) {
          const int t = rb + mi * 32 + crow(q, lh);
          p.x1[(size_t)t * DM + cb + ni * 32 + lr] = f2bf(xrow(p, t)[cb + ni * 32 + lr] + g * acc[mi][ni][q]);
        }
      }
    }
  }
};
struct EpiFF1 {
  u16* hid;
  template <int MI, int NI>
  __device__ __forceinline__ void operator()(f32x16 (&acc)[MI][NI], int rb, int cb, int lr, int lh) const {
#pragma unroll
    for (int mi = 0; mi < MI; mi++)
#pragma unroll
      for (int ni = 0; ni < NI; ni++)
#pragma unroll
        for (int q = 0; q < 16; q++) {
          float t = fmaxf(acc[mi][ni][q], 0.f);
          hid[(size_t)(rb + mi * 32 + crow(q, lh)) * DFF + cb + ni * 32 + lr] = f2bf(t * t);
        }
  }
};
#define ST_ROWB 144
struct EpiFF1x16 {
  u16* hid;
  char* smem;
  __device__ __forceinline__ void operator()(f32x4 (&acc)[4][4], int rb, int cb, int r16, int quad) const {
    char* wsm = smem + (threadIdx.x >> 6) * (64 * ST_ROWB);
#pragma unroll
    for (int mi = 0; mi < 4; mi++)
#pragma unroll
      for (int ni = 0; ni < 4; ni++)
#pragma unroll
        for (int j = 0; j < 4; j++) {
          float t = fmaxf(acc[mi][ni][j], 0.f);
          *(u16*)(wsm + (mi * 16 + quad * 4 + j) * ST_ROWB + (ni * 16 + r16) * 2) = f2bf(t * t);
        }
    __builtin_amdgcn_wave_barrier();
    const int lane = threadIdx.x & 63, r0 = lane >> 3, ch = lane & 7;
    u16* dst = hid + (size_t)rb * DFF + cb;
#pragma unroll
    for (int i = 0; i < 8; i++) {
      const int row = r0 + 8 * i;
      *(uint4*)(dst + (size_t)row * DFF + ch * 8) = *(const uint4*)(wsm + row * ST_ROWB + ch * 16);
    }
    __syncthreads();
  }
};
struct EpiWo16 {
  const P& p;
  char* smem;
  template <int MT, int NT>
  __device__ __forceinline__ void operator()(f32x4 (&acc)[MT][NT], int rb, int cb, int r16, int quad) const {
    const int cl0 = cb & 127, rl0 = rb % 96;
#pragma unroll
    for (int mi = 0; mi < MT; mi++) {
      const float* md = p.mod + tok_cond(rb + mi * 16) * MODN + 2048 + cb + r16;
#pragma unroll
      for (int ni = 0; ni < NT; ni++) {
        const float g = md[ni * 16];
#pragma unroll
        for (int j = 0; j < 4; j++) {
          const int rl = mi * 16 + quad * 4 + j;
          const float v = __builtin_nontemporal_load(xrow(p, rb + rl) + cb + ni * 16 + r16) + g * acc[mi][ni][j];
          *(u16*)(smem + (rl0 + rl) * 272 + (cl0 + ni * 16 + r16) * 2) = f2bf(v);
        }
      }
    }
    __syncthreads();
    u16* dst = p.x1 + (size_t)(rb - rl0) * DM + (cb & ~127);
#pragma unroll
    for (int i = 0; i < 6; i++) {
      const int id = threadIdx.x + 256 * i, row = id >> 4, c16 = id & 15;
      *(uint4*)(dst + (size_t)row * DM + c16 * 8) = *(const uint4*)(smem + row * 272 + c16 * 16);
    }
    __syncthreads();
  }
};
struct EpiFF2x16 {
  const P& p;
  template <int MT, int NT>
  __device__ __forceinline__ void operator()(f32x4 (&acc)[MT][NT], int rb, int cb, int r16, int quad) const {
#pragma unroll
    for (int mi = 0; mi < MT; mi++) {
      const float* md = p.mod + tok_cond(rb + mi * 16) * MODN + 5120 + cb + r16;
#pragma unroll
      for (int ni = 0; ni < NT; ni++) {
        const float g = md[ni * 16];
#pragma unroll
        for (int j = 0; j < 4; j++) {
          const size_t o = (size_t)(rb + mi * 16 + quad * 4 + j) * DM + cb + ni * 16 + r16;
          st_nt(p.out + o, bf2f(p.x1[o]) + g * acc[mi][ni][j]);
        }
      }
    }
  }
};
struct EpiFF2 {
  const P& p;
  template <int MI, int NI>
  __device__ __forceinline__ void operator()(f32x16 (&acc)[MI][NI], int rb, int cb, int lr, int lh) const {
#pragma unroll
    for (int mi = 0; mi < MI; mi++) {
      const float* md = p.mod + tok_cond(rb + mi * 32) * MODN + 5120 + cb + lr;
#pragma unroll
      for (int ni = 0; ni < NI; ni++) {
        const float g = md[ni * 32];
#pragma unroll
        for (int q = 0; q < 16; q++) {
          const size_t o = (size_t)(rb + mi * 32 + crow(q, lh)) * DM + cb + ni * 32 + lr;
          st_nt(p.out + o, bf2f(p.x1[o]) + g * acc[mi][ni][q]);
        }
      }
    }
  }
};

__device__ void phase_attn_gla1(const P& p, char* smem, volatile unsigned* slot) {
  const int nsh = (gridDim.x & 7) == 0 ? 8 : 1, sh = nsh == 8 ? (int)(blockIdx.x & 7) : 0;
  unsigned* ctr = p.bar + QWORDS1 + sh * 64;
  unsigned nxt = 0;
  if (threadIdx.x == 0) nxt = atomicAdd(ctr, 1u);
  for (;;) {
    __syncthreads();
    if (threadIdx.x == 0) *slot = nxt;
    __syncthreads();
    const int it = (int)*slot * nsh + sh;
    if (it >= 192 + N_ATT_ITEMS + 768) break;
    if (threadIdx.x == 0) nxt = atomicAdd(ctr, 1u);
    if (it < 192) {
      gemm_glds16<4, 4, 2, 2>(p.hbuf, p.WinT, NTOK, NPROJ, 1024, EpiGG16{p.gg, smem}, 12 * 48 + it, 1 << 30, smem);
    } else if (it < 192 + N_ATT_ITEMS) attn_item(p, it - 192, smem);
    else gla_pass1_item(p, it - 192 - N_ATT_ITEMS, smem);
  }
}
__device__ void phase_scan(const P& p, int bid, int nblk) {
  for (int it = bid; it < 1152; it += nblk) gla_scan_item(p, it);
}
__device__ void phase_gla2(const P& p, int bid, int nblk, char* smem) {
  for (int it = bid; it < 768; it += nblk) gla_pass2_item(p, it, smem);
}


#define XB_TMO      128
#define XB_XCNT(j)  (256  + 64 * (j))
#define XB_XSUB(j)  (1280 + 64 * (j))
#define XB_XGEN(j)  (2304 + 64 * (j))
#define XB_TOP      3328
#define XB_TOPGEN   3392
#define XB_SPIN_CAP (1u << 18)
#define LAS __attribute__((address_space(3)))
__device__ __forceinline__ unsigned xb_ld(unsigned* p) { return __hip_atomic_load(p, __ATOMIC_RELAXED, __HIP_MEMORY_SCOPE_AGENT); }
__device__ __forceinline__ unsigned xb_add(unsigned* p, unsigned v) { return __hip_atomic_fetch_add(p, v, __ATOMIC_RELAXED, __HIP_MEMORY_SCOPE_AGENT); }
__device__ __forceinline__ unsigned xb_xcc_id() { return (unsigned)__builtin_amdgcn_s_getreg((3 << 11) | 20) & 0xFu; }
#define XB_SPIN(cond, bar) do { unsigned _sp = 0; while (cond) { __builtin_amdgcn_s_sleep(1); \
    if ((++_sp & 255u) == 0u) { if (xb_ld(&(bar)[XB_TMO])) break; if (_sp > XB_SPIN_CAP) { atomicAdd(&(bar)[XB_TMO], 1u); break; } } } } while (0)
struct XcdBarrier { unsigned* bar; unsigned x; volatile LAS unsigned* st; };
__device__ __forceinline__ XcdBarrier xcd_barrier_post(unsigned* bar, volatile LAS unsigned* st) {
  XcdBarrier b; b.bar = bar; b.x = xb_xcc_id(); b.st = st;
  if (threadIdx.x == 0) (void)xb_add(&bar[XB_XCNT(b.x)], 1u);
  return b;
}
__device__ __forceinline__ void xcd_barrier_complete(unsigned* bar, unsigned x, unsigned& nloc, unsigned& nx) {
  const unsigned G = gridDim.x * gridDim.y * gridDim.z;
  unsigned sum, cnt, mine, sp = 0u;
  for (;;) {
    sum = 0u; cnt = 0u; mine = 0u;
#pragma unroll
    for (unsigned j = 0; j < 16; ++j) { const unsigned c = xb_ld(&bar[XB_XCNT(j)]); sum += c; cnt += (c > 0u) ? 1u : 0u; mine = (j == x) ? c : mine; }
    if (sum == G) break;
    __builtin_amdgcn_s_sleep(1);
    if ((++sp & 255u) == 0u) { if (xb_ld(&bar[XB_TMO])) break; if (sp > XB_SPIN_CAP) { atomicAdd(&bar[XB_TMO], 1u); break; } }
  }
  nloc = mine > 0u ? mine : 1u; nx = cnt > 0u ? cnt : 1u;
}
__device__ __forceinline__ void xcd_barrier(const XcdBarrier& b) {
  asm volatile("s_waitcnt vmcnt(0)" ::: "memory");
  __syncthreads();
  if (threadIdx.x == 0) {
    unsigned* bar = b.bar;
    __builtin_amdgcn_s_waitcnt(0);
    unsigned nloc = b.st[0], nx = b.st[1];
    if (nloc == 0u) { xcd_barrier_complete(bar, b.x, nloc, nx); b.st[0] = nloc; b.st[1] = nx; }
    const unsigned old = xb_add(&bar[XB_XSUB(b.x)], 1u);
    const unsigned gen = old / nloc;
    if (old + 1u == (gen + 1u) * nloc) {
      __builtin_amdgcn_fence(__ATOMIC_RELEASE, "agent");
      asm volatile("s_waitcnt vmcnt(0)" ::: "memory");
      const unsigned og = xb_add(&bar[XB_TOP], 1u);
      const unsigned tg = og / nx;
      if (og + 1u == (tg + 1u) * nx) xb_add(&bar[XB_TOPGEN], 1u);
      else XB_SPIN(xb_ld(&bar[XB_TOPGEN]) == tg, bar);
      __builtin_amdgcn_fence(__ATOMIC_ACQUIRE, "agent");
      xb_add(&bar[XB_XGEN(b.x)], 1u);
      asm volatile("s_waitcnt vmcnt(0)" ::: "memory");
    } else {
      XB_SPIN(xb_ld(&bar[XB_XGEN(b.x)]) == gen, bar);
      __builtin_amdgcn_fence(__ATOMIC_ACQUIRE, "agent");
      asm volatile("s_waitcnt vmcnt(0)" ::: "memory");
    }
  }
  __syncthreads();
}

__global__ void __launch_bounds__(256, 2) mega_kernel(P p) {
  __shared__ __attribute__((aligned(1024))) float sm[16384 + 4];
  float* xbw = sm + 16384;
  cg::grid_group grid = cg::this_grid();
  if (p.never) grid.sync();
  if (threadIdx.x == 0) { xbw[0] = 0.f; xbw[1] = 0.f; xbw[2] = 0.f; xbw[3] = 0.f; }
  __syncthreads();
  XcdBarrier xb = xcd_barrier_post(p.bar, (volatile LAS unsigned*)xbw);
  const int bid = blockIdx.x, nblk = gridDim.x;
  char* smem = (char*)sm;
  phase0(p, bid, nblk, sm);
  xcd_barrier(xb);
  adaln_pass(p, 0, bid, nblk);
  xcd_barrier(xb);
  { EpiProj16 e{p, smem}; gemm_glds16<4, 4, 2, 2>(p.hbuf, p.WinT, NTOK, NPROJ, 1024, e, bid, nblk, smem, 12, 4); }
  phase_queue(p, sm, ((volatile unsigned*)xbw) + 2);
  xcd_barrier(xb);
  phase_attn_gla1(p, smem, ((volatile unsigned*)xbw) + 2);
  xcd_barrier(xb);
  phase_scan(p, bid, nblk);
  xcd_barrier(xb);
  phase_gla2(p, bid, nblk, smem);
  xcd_barrier(xb);
  { EpiWo16 e{p, smem}; gemm_glds16<3, 4, 2, 2>(p.act, p.WoT, NTOK, 1024, 1024, e, bid, nblk, smem); }
  xcd_barrier(xb);
  adaln_pass(p, 1, bid, nblk);
  xcd_barrier(xb);
  { EpiFF1x16 e{p.hid, smem}; gemm_glds16<4, 4, 2, 2>(p.hbuf, p.W1T, NTOK, 4096, 1024, e, bid, nblk, smem, 1 << 30, 0, true); }
  xcd_barrier(xb);
  { EpiFF2x16 e{p}; gemm_glds16<3, 4, 2, 2>(p.hid, p.W2T, NTOK, 1024, 4096, e, bid, nblk, smem); }
}

static inline size_t align_up(size_t x) { return (x + 255) & ~(size_t)255; }

extern "C" void kernel_launch(void* const* d_in, const int* in_sizes, int n_in, void* d_out, int out_size, void* d_ws,
                              size_t ws_size, hipStream_t stream) {
  P p{};
  const float** f = (const float**)&p;
  for (int i = 0; i < 24; i++) f[i] = (const float*)d_in[i];
  p.out = (float*)d_out;
  char* w = (char*)d_ws;
  size_t off = 0;
  auto take = [&](size_t bytes) { void* r = w + off; off += align_up(bytes); return r; };
  p.WinT = (u16*)take((size_t)NPROJ * 1024 * 2);
  p.WoT = (u16*)take((size_t)1024 * 1024 * 2);
  p.W1T = (u16*)take((size_t)4096 * 1024 * 2);
  p.W2T = (u16*)take((size_t)1024 * 4096 * 2);
  p.hbuf = (u16*)take((size_t)NTOK * 1024 * 2);
  p.gq = (u16*)take((size_t)NTOK * 512 * 2);
  p.gk = (u16*)take((size_t)NTOK * 512 * 2);
  p.gvT = (u16*)take((size_t)NTOK * 512 * 2);
  p.gg = (u16*)take((size_t)NTOK * 512 * 2);
  p.sq = (u16*)take((size_t)NTOK * 512 * 2);
  p.sk = (u16*)take((size_t)NTOK * 128 * 2);
  p.svT = (u16*)take((size_t)NTOK * 128 * 2);
  p.ckb = (u16*)take((size_t)2 * 2 * 512 * 64 * 2);
  p.cvT = (u16*)take((size_t)2 * 2 * 512 * 64 * 2);
  p.act = (u16*)take((size_t)NTOK * 1024 * 2);
  p.mod = (float*)take((size_t)3 * MODN * 4);
  p.mod2 = (float*)take((size_t)3 * 2048 * 4);
  p.lr = (float*)take((size_t)NTOK * 32 * 4);
  p.dS = (float*)take((size_t)1536 * 4096 * 4);
  p.dec = (float*)take((size_t)1536 * 64 * 4);
  p.Bst = (float*)take((size_t)1536 * 4096 * 4);
  p.x1 = (u16*)take((size_t)NTOK * 1024 * 2);
  p.hid = (u16*)take((size_t)NTOK * 4096 * 2);
  p.rope = (float2*)take((size_t)1024 * 8);
  p.bar = (unsigned*)take((size_t)BAR_WORDS_TOTAL * 4);
  p.never = 0; p.pad_ = 0;
  (void)ws_size; (void)in_sizes; (void)n_in; (void)out_size;

  static int grid_blocks = 0;
  if (!grid_blocks) {
    int dev = 0, cus = 0, per_cu = 0;
    hipGetDevice(&dev);
    hipDeviceGetAttribute(&cus, hipDeviceAttributeMultiprocessorCount, dev);
    hipOccupancyMaxActiveBlocksPerMultiprocessor(&per_cu, mega_kernel, 256, 0);
    if (per_cu > 2) per_cu = 2;
    if (per_cu < 1) per_cu = 1;
    grid_blocks = cus * per_cu;
  }
  hipMemsetAsync(p.bar, 0, (size_t)BAR_WORDS_TOTAL * 4, stream);
  void* args[] = {&p};
  hipError_t e = hipLaunchCooperativeKernel((void*)mega_kernel, dim3(grid_blocks), dim3(256), args, 0, stream);
  if (e != hipSuccess) fprintf(stderr, "cooperative launch failed: %s (grid %d)\n", hipGetErrorString(e), grid_blocks);
}
```

```cpp
#include <hip/hip_runtime.h>
#include <hip/hip_cooperative_groups.h>
#include <cstdio>
namespace cg = cooperative_groups;

typedef unsigned short u16;

#define NTOK 6144
#define NCTX 4096
#define DM 1024
#define DFF 4096
#define NPROJ 2944
#define MODN 6144
#define XCD_BAR_WORDS 3456

struct P {
  const float *xp, *xs, *c, *cache_k, *cache_v, *sgf, *sgb, *cctx, *w_ada, *b_ada, *norm_mix, *norm_ff,
      *w_in, *wgf, *bgf, *wgb, *bgb, *gla_norm, *q_norm, *k_norm, *sink, *w_o, *w1, *w2;
  float* out;
  u16 *WinT, *WoT, *W1T, *W2T, *hbuf, *gq, *gk, *gvT, *gg, *sq, *sk, *svT, *ckb, *cvT, *act, *hid;
  float *mod, *mod2, *lr, *dS, *dec, *Bst;
  u16* x1;
  float2* rope;
  unsigned* bar;
  int never, pad_;
};

__device__ __forceinline__ u16 f2bf(float f) {
  unsigned u = __float_as_uint(f);
  u += 0x7fffu + ((u >> 16) & 1u);
  return (u16)(u >> 16);
}
__device__ __forceinline__ float bf2f(u16 h) { return __uint_as_float(((unsigned)h) << 16); }
__device__ __forceinline__ float bflo(unsigned w) { return __uint_as_float(w << 16); }
__device__ __forceinline__ float bfhi(unsigned w) { return __uint_as_float(w & 0xffff0000u); }
typedef __attribute__((ext_vector_type(2))) __bf16 bf2_t;
typedef __attribute__((ext_vector_type(2))) float f2_t;
__device__ __forceinline__ unsigned pack2(float a, float b) {
  f2_t v = {a, b};
  bf2_t r = __builtin_convertvector(v, bf2_t);
  return __builtin_bit_cast(unsigned, r);
}
__device__ __forceinline__ float silu_f(float x) { return x / (1.f + expf(-x)); }
__device__ __forceinline__ float logsig_f(float x) { return fminf(x, 0.f) - __logf(1.f + __expf(-fabsf(x))); }
__device__ __forceinline__ float wave_sum(float v) {
#pragma unroll
  for (int o = 32; o >= 1; o >>= 1) v += __shfl_xor(v, o);
  return v;
}
__device__ __forceinline__ float wave_max(float v) {
#pragma unroll
  for (int o = 32; o >= 1; o >>= 1) v = fmaxf(v, __shfl_xor(v, o));
  return v;
}
typedef float f4v __attribute__((ext_vector_type(4)));
__device__ __forceinline__ float4 ld_nt4(const float* p) { f4v v = __builtin_nontemporal_load((const f4v*)p); return make_float4(v.x, v.y, v.z, v.w); }
__device__ __forceinline__ void st_nt(float* p, float v) { __builtin_nontemporal_store(v, p); }
__device__ __forceinline__ int opaque_tid() { int t = threadIdx.x; asm volatile("" : "+v"(t)); return t; }
__device__ __forceinline__ int tok_cond(int t) { return t < NCTX ? 0 : 1 + ((t - NCTX) >> 10); }
__device__ __forceinline__ const float* xrow(const P& p, int t) {
  return t < NCTX ? p.xp + (size_t)t * DM : p.xs + (size_t)(t - NCTX) * DM;
}
__device__ __forceinline__ void tok_seq(int t, int& tok0, int& T, int& s) {
  if (t < NCTX) { tok0 = t & ~255; T = 256; s = t & 255; }
  else { int u = t - NCTX; tok0 = NCTX + (u & ~1023); T = 1024; s = u & 1023; }
}

__device__ void mod_item(const P& p, int it, float* sm, int khalf = -1) {
  float* ssil = sm;
  float* red = sm + 3072;
  const int tid = opaque_tid(), lane = tid & 63, w = tid >> 6;
  for (int i = tid; i < 3072; i += 256) {
    int cd = i >> 10, k = i & 1023;
    float v = cd == 0 ? p.cctx[k] : p.c[(cd - 1) * 1024 + k];
    ssil[i] = silu_f(v);
  }
  __syncthreads();
  const int n0 = it * 32, cl = lane & 7, rg = lane >> 3;
  float a0[4] = {0, 0, 0, 0}, a1[4] = {0, 0, 0, 0}, a2[4] = {0, 0, 0, 0};
  const int kbase = khalf < 0 ? w * 256 : khalf * 512 + w * 128, niter = khalf < 0 ? 32 : 16;
#pragma unroll 16
  for (int i = 0; i < niter; i++) {
    int k = kbase + i * 8 + rg;
    float4 wv = ld_nt4(p.w_ada + (size_t)k * MODN + n0 + cl * 4);
    float s0 = ssil[k], s1 = ssil[1024 + k], s2 = ssil[2048 + k];
    a0[0] += s0 * wv.x; a0[1] += s0 * wv.y; a0[2] += s0 * wv.z; a0[3] += s0 * wv.w;
    a1[0] += s1 * wv.x; a1[1] += s1 * wv.y; a1[2] += s1 * wv.z; a1[3] += s1 * wv.w;
    a2[0] += s2 * wv.x; a2[1] += s2 * wv.y; a2[2] += s2 * wv.z; a2[3] += s2 * wv.w;
  }
#pragma unroll
  for (int j = 0; j < 4; j++) {
    a0[j] += __shfl_xor(a0[j], 8); a0[j] += __shfl_xor(a0[j], 16); a0[j] += __shfl_xor(a0[j], 32);
    a1[j] += __shfl_xor(a1[j], 8); a1[j] += __shfl_xor(a1[j], 16); a1[j] += __shfl_xor(a1[j], 32);
    a2[j] += __shfl_xor(a2[j], 8); a2[j] += __shfl_xor(a2[j], 16); a2[j] += __shfl_xor(a2[j], 32);
  }
  if (rg == 0) {
#pragma unroll
    for (int j = 0; j < 4; j++) {
      red[(w * 3 + 0) * 32 + cl * 4 + j] = a0[j];
      red[(w * 3 + 1) * 32 + cl * 4 + j] = a1[j];
      red[(w * 3 + 2) * 32 + cl * 4 + j] = a2[j];
    }
  }
  __syncthreads();
  if (tid < 96) {
    int cd = tid >> 5, col = tid & 31;
    float v = khalf == 1 ? 0.f : p.b_ada[n0 + col];
    for (int ww = 0; ww < 4; ww++) v += red[(ww * 3 + cd) * 32 + col];
    if (khalf == 1) p.mod2[cd * 2048 + n0 + col] = v;
    else p.mod[cd * MODN + n0 + col] = v;
  }
  __syncthreads();
}

__device__ void conv_tile(const float* src, int ldsrc, int k0, int nsrc0, int nvalid, u16* dst, int nd0, int Kd, float* tile) {
  const int tid = opaque_tid();
#pragma unroll
  for (int i = 0; i < 4; i++) {
    int idx = tid + 256 * i;
    int r = idx >> 4, c4 = (idx & 15) * 4;
    float4 v = make_float4(0.f, 0.f, 0.f, 0.f);
    if (c4 < nvalid) v = ld_nt4(src + (size_t)(k0 + r) * ldsrc + nsrc0 + c4);
    tile[r * 65 + c4 + 0] = v.x; tile[r * 65 + c4 + 1] = v.y; tile[r * 65 + c4 + 2] = v.z; tile[r * 65 + c4 + 3] = v.w;
  }
  __syncthreads();
#pragma unroll
  for (int i = 0; i < 2; i++) {
    int id = tid + 256 * i;
    int n = id >> 3, kc = id & 7;
    float f[8];
#pragma unroll
    for (int j = 0; j < 8; j++) f[j] = tile[(kc * 8 + j) * 65 + n];
    uint4 o;
    o.x = pack2(f[0], f[1]); o.y = pack2(f[2], f[3]); o.z = pack2(f[4], f[5]); o.w = pack2(f[6], f[7]);
    *(uint4*)(dst + (size_t)(nd0 + n) * Kd + k0 + kc * 8) = o;
  }
  __syncthreads();
}

#define N_MOD0_ITEMS 128
#define N_MOD1_ITEMS 128
#define N_WIN_ITEMS (16 * 46)
#define N_WO_ITEMS (16 * 16)
#define N_W1_ITEMS (16 * 64)
#define N_W2_ITEMS (64 * 16)
#define N_CV_ITEMS 32
#define N_CK_ITEMS 32
#define N_P0_ITEMS (N_MOD0_ITEMS + N_WIN_ITEMS + N_CV_ITEMS + N_CK_ITEMS + 1)
#define N_Q_ITEMS (N_MOD1_ITEMS + N_WO_ITEMS + N_W1_ITEMS + N_W2_ITEMS)

__device__ void phase0(const P& p, int bid, int nblk, float* sm) {
  for (int it = bid; it < N_P0_ITEMS; it += nblk) {
    int i = it;
    if (i < N_MOD0_ITEMS) { mod_item(p, i >> 1, sm, i & 1); continue; }
    i -= N_MOD0_ITEMS;
    if (i < N_WIN_ITEMS) {
      int kt = i & 15, nt = i >> 4;
      int nd0 = nt * 64, nsrc0, nvalid;
      if (nd0 < 2048) { nsrc0 = nd0; nvalid = 64; }
      else if (nd0 < 2816) { nsrc0 = nd0 + 32; nvalid = 64; }
      else if (nd0 == 2816) { nsrc0 = 2048; nvalid = 32; }
      else { nsrc0 = 0; nvalid = 0; }
      conv_tile(p.w_in, 2848, kt * 64, nsrc0, nvalid, p.WinT, nd0, 1024, sm);
      continue;
    }
    i -= N_WIN_ITEMS;
    if (i < N_CV_ITEMS) {
      int bk = i >> 3, st = i & 7;
      conv_tile(p.cache_v + (size_t)bk * 512 * 64, 64, st * 64, 0, 64, p.cvT + (size_t)bk * 64 * 512, 0, 512, sm);
      continue;
    }
    i -= N_CV_ITEMS;
    if (i == N_CK_ITEMS) {
#pragma unroll
      for (int j = 0; j < 4; j++) {
        int idx = threadIdx.x + 256 * j;
        float freq = powf(10000.f, -(float)(idx & 15) / 16.f);
        float ang = (float)(idx >> 4) * freq;
        float sn, cs;
        sincosf(ang, &sn, &cs);
        p.rope[idx] = make_float2(cs, sn);
      }
      continue;
    }
    {
      int base = i * 4096 + threadIdx.x * 16;
#pragma unroll
      for (int j = 0; j < 4; j++) {
        float4 v = *(const float4*)(p.cache_k + base + j * 4);
        uint2 o; o.x = pack2(v.x, v.y); o.y = pack2(v.z, v.w);
        *(uint2*)(p.ckb + base + j * 4) = o;
      }
    }
  }
}

#define QWORDS0 (XCD_BAR_WORDS + 64)
#define QWORDS1 (XCD_BAR_WORDS + 64 + 512)
#define BAR_WORDS_TOTAL (XCD_BAR_WORDS + 64 + 1024)
__device__ void phase_queue(const P& p, float* sm, volatile unsigned* slot) {
  const int nsh = (gridDim.x & 7) == 0 ? 8 : 1, sh = nsh == 8 ? (int)(blockIdx.x & 7) : 0;
  unsigned* ctr = p.bar + QWORDS0 + sh * 64;
  unsigned nxt = 0;
  if (threadIdx.x == 0) nxt = atomicAdd(ctr, 1u);
  for (;;) {
    __syncthreads();
    if (threadIdx.x == 0) *slot = nxt;
    __syncthreads();
    int i = (int)*slot * nsh + sh;
    if (i >= N_Q_ITEMS) break;
    if (threadIdx.x == 0) nxt = atomicAdd(ctr, 1u);
    if (i < N_MOD1_ITEMS) { mod_item(p, 64 + i, sm); continue; }
    i -= N_MOD1_ITEMS;
    if (i < N_WO_ITEMS) { int kt = i & 15, nt = i >> 4; conv_tile(p.w_o, 1024, kt * 64, nt * 64, 64, p.WoT, nt * 64, 1024, sm); continue; }
    i -= N_WO_ITEMS;
    if (i < N_W1_ITEMS) { int kt = i & 15, nt = i >> 4; conv_tile(p.w1, 4096, kt * 64, nt * 64, 64, p.W1T, nt * 64, 1024, sm); continue; }
    i -= N_W1_ITEMS;
    { int kt = i & 63, nt = i >> 6; conv_tile(p.w2, 1024, kt * 64, nt * 64, 64, p.W2T, nt * 64, 4096, sm); }
  }
}

__device__ void adaln_pass(const P& p, int which, int bid, int nblk) {
  const int lane = threadIdx.x & 63, w = threadIdx.x >> 6;
  const float* gain = which ? p.norm_ff : p.norm_mix;
  for (int t = bid * 4 + w; t < NTOK; t += nblk * 4) {
    const float* md = p.mod + tok_cond(t) * MODN + (which ? 3072 : 0);
    float v[16];
    if (which) {
#pragma unroll
      for (int i = 0; i < 2; i++) {
        const uint4 u = *(const uint4*)(p.x1 + (size_t)t * DM + i * 512 + lane * 8);
        v[i * 8 + 0] = bflo(u.x); v[i * 8 + 1] = bfhi(u.x); v[i * 8 + 2] = bflo(u.y); v[i * 8 + 3] = bfhi(u.y);
        v[i * 8 + 4] = bflo(u.z); v[i * 8 + 5] = bfhi(u.z); v[i * 8 + 6] = bflo(u.w); v[i * 8 + 7] = bfhi(u.w);
      }
    } else {
      const float* x = xrow(p, t);
#pragma unroll
      for (int i = 0; i < 2; i++) {
        const float4 a = ld_nt4(x + i * 512 + lane * 8), b = ld_nt4(x + i * 512 + lane * 8 + 4);
        v[i * 8 + 0] = a.x; v[i * 8 + 1] = a.y; v[i * 8 + 2] = a.z; v[i * 8 + 3] = a.w;
        v[i * 8 + 4] = b.x; v[i * 8 + 5] = b.y; v[i * 8 + 6] = b.z; v[i * 8 + 7] = b.w;
      }
    }
    float ss = 0.f;
#pragma unroll
    for (int j = 0; j < 16; j++) ss += v[j] * v[j];
    ss = wave_sum(ss);
    const float rstd = rsqrtf(ss * (1.f / 1024.f) + 1e-6f);
#pragma unroll
    for (int i = 0; i < 2; i++) {
      const int col = i * 512 + lane * 8;
      float o[8];
#pragma unroll
      for (int h = 0; h < 2; h++) {
        const float4 g = *(const float4*)(gain + col + 4 * h);
        float4 sh = *(const float4*)(md + col + 4 * h);
        float4 sc = *(const float4*)(md + 1024 + col + 4 * h);
        if (!which) {
          const float* m2 = p.mod2 + tok_cond(t) * 2048;
          const float4 sh2 = *(const float4*)(m2 + col + 4 * h), sc2 = *(const float4*)(m2 + 1024 + col + 4 * h);
          sh.x += sh2.x; sh.y += sh2.y; sh.z += sh2.z; sh.w += sh2.w;
          sc.x += sc2.x; sc.y += sc2.y; sc.z += sc2.z; sc.w += sc2.w;
        }
        o[4 * h + 0] = v[i * 8 + 4 * h + 0] * rstd * g.x * (1.f + sc.x) + sh.x;
        o[4 * h + 1] = v[i * 8 + 4 * h + 1] * rstd * g.y * (1.f + sc.y) + sh.y;
        o[4 * h + 2] = v[i * 8 + 4 * h + 2] * rstd * g.z * (1.f + sc.z) + sh.z;
        o[4 * h + 3] = v[i * 8 + 4 * h + 3] * rstd * g.w * (1.f + sc.w) + sh.w;
      }
      uint4 ov;
      ov.x = pack2(o[0], o[1]); ov.y = pack2(o[2], o[3]); ov.z = pack2(o[4], o[5]); ov.w = pack2(o[6], o[7]);
      *(uint4*)(p.hbuf + (size_t)t * DM + col) = ov;
    }
  }
}

using bf16x8 = __attribute__((ext_vector_type(8))) short;
using f32x16 = __attribute__((ext_vector_type(16))) float;
#define MFMA32(a, b, c) __builtin_amdgcn_mfma_f32_32x32x16_bf16((a), (b), (c), 0, 0, 0)
__device__ __forceinline__ int swz(int row, int ch) { return row * 128 + ((ch ^ ((row >> 1) & 7)) << 4); }
__device__ __forceinline__ int crow(int reg, int hh) { return (reg & 3) + 8 * (reg >> 2) + 4 * hh; }

template <int MI, int NI, int WM, int WN, class Epi>
__device__ void gemm_mfma(const u16* __restrict__ A, const u16* __restrict__ Bt, int M, int N, int K, const Epi& epi,
                          int bid, int nblk, char* smem) {
  constexpr int BM = 32 * MI * WM, BN = 32 * NI * WN, LA = BM / 32, LB = BN / 32;
  static_assert(WM * WN == 4 && BM <= 128 && BN <= 128, "tile");
  const int tid = opaque_tid(), lane = tid & 63, wv = tid >> 6, wm = wv / WN, wn = wv % WN;
  const int tm = M / BM, tn = N / BN, KT = K >> 6;
  const int lr = lane & 31, lh = lane >> 5;
  const int lrow = tid >> 3, lch = tid & 7;
  for (int it = bid; it < tm * tn; it += nblk) {
    const int mt = it % tm, nt = it / tm;
    const u16* Ag = A + (size_t)(mt * BM + lrow) * K + lch * 8;
    const u16* Bg = Bt + (size_t)(nt * BN + lrow) * K + lch * 8;
    f32x16 acc[MI][NI];
#pragma unroll
    for (int mi = 0; mi < MI; mi++)
#pragma unroll
      for (int ni = 0; ni < NI; ni++)
#pragma unroll
        for (int r = 0; r < 16; r++) acc[mi][ni][r] = 0.f;
    uint4 ra[LA], rb[LB];
#pragma unroll
    for (int i = 0; i < LA; i++) ra[i] = *(const uint4*)(Ag + (size_t)(32 * i) * K);
#pragma unroll
    for (int i = 0; i < LB; i++) rb[i] = *(const uint4*)(Bg + (size_t)(32 * i) * K);
#pragma unroll
    for (int i = 0; i < LA; i++) *(uint4*)(smem + swz(lrow + 32 * i, lch)) = ra[i];
#pragma unroll
    for (int i = 0; i < LB; i++) *(uint4*)(smem + 16384 + swz(lrow + 32 * i, lch)) = rb[i];
    __syncthreads();
    for (int kt = 0; kt < KT; kt++) {
      const char* sA = smem + (kt & 1) * 32768;
      const char* sB = sA + 16384;
      if (kt + 1 < KT) {
#pragma unroll
        for (int i = 0; i < LA; i++) ra[i] = *(const uint4*)(Ag + (size_t)(32 * i) * K + (kt + 1) * 64);
#pragma unroll
        for (int i = 0; i < LB; i++) rb[i] = *(const uint4*)(Bg + (size_t)(32 * i) * K + (kt + 1) * 64);
      }
#pragma unroll
      for (int kk = 0; kk < 4; kk++) {
        bf16x8 a[MI], b[NI];
        const int ch = kk * 2 + lh;
#pragma unroll
        for (int mi = 0; mi < MI; mi++) a[mi] = *(const bf16x8*)(sA + swz((wm * MI + mi) * 32 + lr, ch));
#pragma unroll
        for (int ni = 0; ni < NI; ni++) b[ni] = *(const bf16x8*)(sB + swz((wn * NI + ni) * 32 + lr, ch));
#pragma unroll
        for (int mi = 0; mi < MI; mi++)
#pragma unroll
          for (int ni = 0; ni < NI; ni++) acc[mi][ni] = MFMA32(a[mi], b[ni], acc[mi][ni]);
      }
      if (kt + 1 < KT) {
        char* dA = smem + ((kt + 1) & 1) * 32768;
#pragma unroll
        for (int i = 0; i < LA; i++) *(uint4*)(dA + swz(lrow + 32 * i, lch)) = ra[i];
#pragma unroll
        for (int i = 0; i < LB; i++) *(uint4*)(dA + 16384 + swz(lrow + 32 * i, lch)) = rb[i];
      }
      __syncthreads();
    }
    epi(acc, mt * BM + wm * MI * 32, nt * BN + wn * NI * 32, lr, lh);
  }
}

#define WAIT_V0() asm volatile("s_waitcnt vmcnt(0)" ::: "memory")
template <int MI, int NI, int WM, int WN, class Epi>
__device__ void gemm_glds(const u16* __restrict__ A, const u16* __restrict__ Bt, int M, int N, int K, const Epi& epi,
                          int bid, int nblk, char* smem, int gap_at = 1 << 30, int gap = 0, bool pair = false) {
  constexpr int BM = 32 * MI * WM, BN = 32 * NI * WN, LA = BM / 32, LB = BN / 32;
  static_assert(WM * WN == 4 && BM <= 128 && BN <= 128, "tile");
  const int tid = opaque_tid(), lane = tid & 63, wv = tid >> 6, wm = wv / WN, wn = wv % WN;
  const int tm = M / BM, tn = N / BN - gap, KT = K >> 6;
  const int lr = lane & 31, lh = lane >> 5;
  const int srow = lane >> 3, pch = lane & 7;
  for (int it = bid; it < tm * tn; it += nblk) {
    int mt, nt;
    const int rnd = it / nblk;
    if (pair && (tn & 1) == 0) {
      int q = it;
      if ((nblk & 15) == 0 && (rnd + 1) * nblk <= tm * tn) {
        const int b0 = it - rnd * nblk;
        q = ((((b0 >> 4) << 3) + (b0 & 7)) << 1) + ((b0 >> 3) & 1) + rnd * nblk;
      }
      mt = (q >> 1) % tm; nt = ((q >> 1) / tm) * 2 + (q & 1);
    } else { mt = it % tm; nt = it / tm; }
    nt += (nt >= gap_at ? gap : 0);
    const u16* Ab = A + (size_t)(mt * BM) * K;
    const u16* Bb = Bt + (size_t)(nt * BN) * K;
    f32x16 acc[MI][NI];
#pragma unroll
    for (int mi = 0; mi < MI; mi++)
#pragma unroll
      for (int ni = 0; ni < NI; ni++)
#pragma unroll
        for (int r = 0; r < 16; r++) acc[mi][ni][r] = 0.f;
#define GLDS_STAGE(buf, kt)                                                                                              \
  do {                                                                                                                   \
    _Pragma("unroll") for (int i = 0; i < LA; i++) {                                                                     \
      const int u_ = wv + 4 * i, row_ = 8 * u_ + srow, c_ = pch ^ ((row_ >> 1) & 7);                                      \
      __builtin_amdgcn_global_load_lds((const unsigned*)(Ab + (size_t)row_ * K + (kt) * 64 + c_ * 8),                    \
                                       (unsigned*)(smem + (buf) * 32768 + u_ * 1024), 16, 0, 0);                         \
    }                                                                                                                    \
    _Pragma("unroll") for (int i = 0; i < LB; i++) {                                                                     \
      const int u_ = wv + 4 * i, row_ = 8 * u_ + srow, c_ = pch ^ ((row_ >> 1) & 7);                                      \
      __builtin_amdgcn_global_load_lds((const unsigned*)(Bb + (size_t)row_ * K + (kt) * 64 + c_ * 8),                    \
                                       (unsigned*)(smem + (buf) * 32768 + 16384 + u_ * 1024), 16, 0, 0);                 \
    }                                                                                                                    \
  } while (0)
    GLDS_STAGE(0, 0);
    WAIT_V0();
    __syncthreads();
    for (int kt = 0; kt < KT; kt++) {
      const char* sA = smem + (kt & 1) * 32768;
      const char* sB = sA + 16384;
      if (kt + 1 < KT) GLDS_STAGE((kt + 1) & 1, kt + 1);
#pragma unroll
      for (int kk = 0; kk < 4; kk++) {
        bf16x8 a[MI], b[NI];
        const int ch = kk * 2 + lh;
#pragma unroll
        for (int mi = 0; mi < MI; mi++) a[mi] = *(const bf16x8*)(sA + swz((wm * MI + mi) * 32 + lr, ch));
#pragma unroll
        for (int ni = 0; ni < NI; ni++) b[ni] = *(const bf16x8*)(sB + swz((wn * NI + ni) * 32 + lr, ch));
        __builtin_amdgcn_s_setprio(1);
#pragma unroll
        for (int mi = 0; mi < MI; mi++)
#pragma unroll
          for (int ni = 0; ni < NI; ni++) acc[mi][ni] = MFMA32(a[mi], b[ni], acc[mi][ni]);
        __builtin_amdgcn_s_setprio(0);
      }
      WAIT_V0();
      __syncthreads();
    }
#undef GLDS_STAGE
    epi(acc, mt * BM + wm * MI * 32, nt * BN + wn * NI * 32, lr, lh);
  }
}

using f32x4 = __attribute__((ext_vector_type(4))) float;
template <int MT, int NT, int WM, int WN, class Epi>
__device__ void gemm_glds16(const u16* __restrict__ A, const u16* __restrict__ Bt, int M, int N, int K, const Epi& epi,
                          int bid, int nblk, char* smem, int gap_at = 1 << 30, int gap = 0, bool pair = false) {
  constexpr int BM = 16 * MT * WM, BN = 16 * NT * WN, LA = BM / 32, LB = BN / 32;
  static_assert(WM * WN == 4 && BM <= 128 && BN <= 128, "tile");
  const int tid = opaque_tid(), lane = tid & 63, wv = tid >> 6, wm = wv / WN, wn = wv % WN;
  const int tm = M / BM, tn = N / BN - gap, KT = K >> 6;
  const int r16 = lane & 15, quad = lane >> 4;
  const int srow = lane >> 3, pch = lane & 7;
  for (int it = bid; it < tm * tn; it += nblk) {
    int mt, nt;
    const int rnd = it / nblk;
    if (pair && (tn & 1) == 0) {
      int q = it;
      if ((nblk & 15) == 0 && (rnd + 1) * nblk <= tm * tn) {
        const int b0 = it - rnd * nblk;
        q = ((((b0 >> 4) << 3) + (b0 & 7)) << 1) + ((b0 >> 3) & 1) + rnd * nblk;
      }
      mt = (q >> 1) % tm; nt = ((q >> 1) / tm) * 2 + (q & 1);
    } else { mt = it % tm; nt = it / tm; }
    nt += (nt >= gap_at ? gap : 0);
    const u16* Ab = A + (size_t)(mt * BM) * K;
    const u16* Bb = Bt + (size_t)(nt * BN) * K;
    f32x4 acc[MT][NT];
#pragma unroll
    for (int mi = 0; mi < MT; mi++)
#pragma unroll
      for (int ni = 0; ni < NT; ni++)
#pragma unroll
        for (int r = 0; r < 4; r++) acc[mi][ni][r] = 0.f;
#define GLDS_STAGE(buf, kt)                                                                                              \
  do {                                                                                                                   \
    _Pragma("unroll") for (int i = 0; i < LA; i++) {                                                                     \
      const int u_ = wv + 4 * i, row_ = 8 * u_ + srow, c_ = pch ^ ((row_ >> 1) & 7);                                      \
      __builtin_amdgcn_global_load_lds((const unsigned*)(Ab + (size_t)row_ * K + (kt) * 64 + c_ * 8),                    \
                                       (unsigned*)(smem + (buf) * 32768 + u_ * 1024), 16, 0, 0);                         \
    }                                                                                                                    \
    _Pragma("unroll") for (int i = 0; i < LB; i++) {                                                                     \
      const int u_ = wv + 4 * i, row_ = 8 * u_ + srow, c_ = pch ^ ((row_ >> 1) & 7);                                      \
      __builtin_amdgcn_global_load_lds((const unsigned*)(Bb + (size_t)row_ * K + (kt) * 64 + c_ * 8),                    \
                                       (unsigned*)(smem + (buf) * 32768 + 16384 + u_ * 1024), 16, 0, 0);                 \
    }                                                                                                                    \
  } while (0)
    GLDS_STAGE(0, 0);
    WAIT_V0();
    __syncthreads();
    for (int kt = 0; kt < KT; kt++) {
      const char* sA = smem + (kt & 1) * 32768;
      const char* sB = sA + 16384;
      if (kt + 1 < KT) GLDS_STAGE((kt + 1) & 1, kt + 1);
      bf16x8 a[2][MT], b[2][NT];
#pragma unroll
      for (int ks = 0; ks < 2; ks++) {
        const int ch = ks * 4 + quad;
#pragma unroll
        for (int mi = 0; mi < MT; mi++) a[ks][mi] = *(const bf16x8*)(sA + swz((wm * MT + mi) * 16 + r16, ch));
#pragma unroll
        for (int ni = 0; ni < NT; ni++) b[ks][ni] = *(const bf16x8*)(sB + swz((wn * NT + ni) * 16 + r16, ch));
      }
      __builtin_amdgcn_sched_barrier(0);
      __builtin_amdgcn_s_setprio(1);
#pragma unroll
      for (int ks = 0; ks < 2; ks++) {
#pragma unroll
        for (int mi = 0; mi < MT; mi++)
#pragma unroll
          for (int ni = 0; ni < NT; ni++) acc[mi][ni] = __builtin_amdgcn_mfma_f32_16x16x32_bf16(a[ks][mi], b[ks][ni], acc[mi][ni], 0, 0, 0);
      }
      __builtin_amdgcn_s_setprio(0);
      WAIT_V0();
      __syncthreads();
    }
#undef GLDS_STAGE
    {
      int er = mt * BM + wm * MT * 16, ec = nt * BN + wn * NT * 16, e16 = r16, eq = quad;
      asm volatile("" : "+v"(er), "+v"(ec), "+v"(e16), "+v"(eq));
      epi(acc, __builtin_amdgcn_readfirstlane(er), __builtin_amdgcn_readfirstlane(ec), e16, eq);
    }
  }
}

using u32x4 = __attribute__((ext_vector_type(4))) unsigned;
__device__ __forceinline__ bf16x8 pack8(float a, float b, float c, float d, float e, float f, float g, float h) {
  u32x4 u; u[0] = pack2(a, b); u[1] = pack2(c, d); u[2] = pack2(e, f); u[3] = pack2(g, h);
  return __builtin_bit_cast(bf16x8, u);
}
#define PACKX(X, s) pack8(X[8 * (s)], X[8 * (s) + 1], X[8 * (s) + 2], X[8 * (s) + 3], X[8 * (s) + 4], X[8 * (s) + 5], X[8 * (s) + 6], X[8 * (s) + 7])

__device__ __forceinline__ void gla_geom(int it, int& h, int& T, int& tok0, int& s0) {
  h = it & 7;
  int ci = it >> 3;
  if (ci < 64) { T = 256; tok0 = (ci >> 2) * 256; s0 = (ci & 3) * 64; }
  else { int u = ci - 64; T = 1024; tok0 = NCTX + (u >> 4) * 1024; s0 = (u & 15) * 64; }
}

__device__ __forceinline__ void gla_gate_prefix(int dir, const float* wsm, float2 bb, const float* lrs, float* Bs, float* tot) {
  const int tid = opaque_tid(), dp = tid & 31, seg = tid >> 5, d0 = dp * 2;
  float w0[16], w1[16];
#pragma unroll
  for (int r = 0; r < 16; r++) { float2 v = *(const float2*)(wsm + dir * 1024 + r * 64 + d0); w0[r] = v.x; w1[r] = v.y; }
  float run0 = 0.f, run1 = 0.f;
#pragma unroll
  for (int i = 0; i < 8; i++) {
    const int j = seg * 8 + i;
    const float* l = lrs + j * 32 + dir * 16;
    float x0 = bb.x, x1 = bb.y;
#pragma unroll
    for (int r = 0; r < 16; r++) { float lv = l[r]; x0 += lv * w0[r]; x1 += lv * w1[r]; }
    run0 += logsig_f(x0) * (1.f / 16.f);
    run1 += logsig_f(x1) * (1.f / 16.f);
    *(float2*)(Bs + j * 64 + d0) = make_float2(run0, run1);
  }
  *(float2*)(tot + seg * 64 + d0) = make_float2(run0, run1);
  __syncthreads();
  float o0 = 0.f, o1 = 0.f;
  for (int s2 = 0; s2 < seg; s2++) { o0 += tot[s2 * 64 + d0]; o1 += tot[s2 * 64 + d0 + 1]; }
#pragma unroll
  for (int i = 0; i < 8; i++) {
    const int j = seg * 8 + i;
    float2 v = *(float2*)(Bs + j * 64 + d0);
    v.x += o0; v.y += o1;
    *(float2*)(Bs + j * 64 + d0) = v;
  }
  __syncthreads();
}

__device__ void gla_pass1_item(const P& p, int it, char* smem) {
  int h, T, tok0, s0;
  gla_geom(it, h, T, tok0, s0);
  const int t0 = tok0 + s0;
  float* lrs = (float*)smem; float* Bs = (float*)(smem + 8192); float* tot = (float*)(smem + 24576);
  char* KhT = smem + 26624;
  const int tid = opaque_tid(), lane = tid & 63, wv = tid >> 6, wr = wv >> 1, wc = wv & 1, r = lane & 31, hh = lane >> 5;
  const int dp = tid & 31, seg = tid >> 5, d0 = dp * 2;
#pragma unroll
  for (int i = 0; i < 2; i++) { int idx = tid + 256 * i; ((float4*)lrs)[idx] = ((const float4*)(p.lr + (size_t)t0 * 32))[idx]; }
  float* wsm = (float*)(smem + 36864);
#pragma unroll
  for (int i = 0; i < 2; i++) {
    const int idx = tid + 256 * i, wd = idx >> 8, wr_ = (idx >> 4) & 15, c4 = (idx & 15) * 4;
    ((float4*)wsm)[idx] = *(const float4*)((wd ? p.wgb : p.wgf) + wr_ * 512 + h * 64 + c4);
  }
  const float2 bbf = *(const float2*)(p.bgf + h * 64 + d0), bbb = *(const float2*)(p.bgb + h * 64 + d0);
  bf16x8 vf[4];
#pragma unroll
  for (int ks = 0; ks < 4; ks++)
    vf[ks] = *(const bf16x8*)(p.gvT + (size_t)tok0 * 512 + (size_t)(h * 64 + 32 * wc + r) * T + s0 + ks * 16 + 8 * hh);
  unsigned kk[8];
#pragma unroll
  for (int i = 0; i < 8; i++) kk[i] = *(const unsigned*)(p.gk + (size_t)(t0 + seg * 8 + i) * 512 + h * 64 + d0);
  __syncthreads();
#pragma unroll
  for (int dir = 0; dir < 2; dir++) {
    gla_gate_prefix(dir, wsm, dir ? bbb : bbf, lrs, Bs, tot);
    {
      float4* bd = (float4*)(p.Bst + ((size_t)it * 2 + dir) * 4096);
#pragma unroll
      for (int i = 0; i < 4; i++) bd[tid + 256 * i] = ((const float4*)Bs)[tid + 256 * i];
    }
    float v0[8], v1[8];
    const float tl0 = Bs[63 * 64 + d0], tl1 = Bs[63 * 64 + d0 + 1];
#pragma unroll
    for (int i = 0; i < 8; i++) {
      const int j = seg * 8 + i;
      float f0, f1;
      if (dir == 0) { f0 = __expf(tl0 - Bs[j * 64 + d0]); f1 = __expf(tl1 - Bs[j * 64 + d0 + 1]); }
      else { f0 = j > 0 ? __expf(Bs[(j - 1) * 64 + d0]) : 1.f; f1 = j > 0 ? __expf(Bs[(j - 1) * 64 + d0 + 1]) : 1.f; }
      v0[i] = bflo(kk[i]) * f0;
      v1[i] = bfhi(kk[i]) * f1;
    }
    *(bf16x8*)(KhT + swz(d0, seg)) = pack8(v0[0], v0[1], v0[2], v0[3], v0[4], v0[5], v0[6], v0[7]);
    *(bf16x8*)(KhT + swz(d0 + 1, seg)) = pack8(v1[0], v1[1], v1[2], v1[3], v1[4], v1[5], v1[6], v1[7]);
    if (seg == 7) *(float2*)(p.dec + ((size_t)it * 2 + dir) * 64 + d0) = make_float2(__expf(tl0), __expf(tl1));
    __syncthreads();
    f32x16 acc;
#pragma unroll
    for (int q = 0; q < 16; q++) acc[q] = 0.f;
#pragma unroll
    for (int ks = 0; ks < 4; ks++) {
      bf16x8 a = *(const bf16x8*)(KhT + swz(32 * wr + r, ks * 2 + hh));
      acc = MFMA32(a, vf[ks], acc);
    }
    float* dst = p.dS + ((size_t)it * 2 + dir) * 4096 + (32 * wc + r) * 64 + 32 * wr + 4 * hh;
#pragma unroll
    for (int g = 0; g < 4; g++) *(float4*)(dst + 8 * g) = make_float4(acc[4 * g], acc[4 * g + 1], acc[4 * g + 2], acc[4 * g + 3]);
    __syncthreads();
  }
}

__device__ void gla_scan_item(const P& p, int it) {
  const int part = it & 3, dir = (it >> 2) & 1, h = (it >> 3) & 7, seq = it >> 6;
  const int n = seq < 16 ? 4 : 16;
  const int cibase = seq < 16 ? seq * 4 : 64 + (seq - 16) * 16;
  const int idx = part * 1024 + threadIdx.x * 4, e = idx >> 6, d = idx & 63;
  float4 S = make_float4(0.f, 0.f, 0.f, 0.f);
  if (seq >= 16) {
    const float* s0 = (dir ? p.sgb : p.sgf) + (size_t)((seq - 16) * 8 + h) * 4096;
    S = make_float4(s0[d * 64 + e], s0[(d + 1) * 64 + e], s0[(d + 2) * 64 + e], s0[(d + 3) * 64 + e]);
  }
  for (int k = 0; k < n; k++) {
    const int c = dir ? n - 1 - k : k;
    const size_t item = ((size_t)(cibase + c) * 8 + h) * 2 + dir;
    float4* ptr = (float4*)(p.dS + item * 4096 + idx);
    const float4 dv = *ptr;
    const float4 dc = *(const float4*)(p.dec + item * 64 + d);
    *ptr = S;
    S.x = dc.x * S.x + dv.x; S.y = dc.y * S.y + dv.y; S.z = dc.z * S.z + dv.z; S.w = dc.w * S.w + dv.w;
  }
  if (seq < 16) {
    float* so = p.out + (dir ? 7864320 : 7340032) + (size_t)(seq * 8 + h) * 4096;
    so[d * 64 + e] = S.x; so[(d + 1) * 64 + e] = S.y; so[(d + 2) * 64 + e] = S.z; so[(d + 3) * 64 + e] = S.w;
  }
}

__device__ void gla_pass2_item(const P& p, int it, char* smem) {
  int h, T, tok0, s0;
  gla_geom(it, h, T, tok0, s0);
  const int t0 = tok0 + s0;
  float* red = (float*)smem;
  const int tid = opaque_tid(), lane = tid & 63, wv = tid >> 6, wr = wv >> 1, wc = wv & 1, r = lane & 31, hh = lane >> 5;
  const int dp = tid & 31, seg = tid >> 5, d0 = dp * 2;
  unsigned qq[8], kk[8];
#pragma unroll
  for (int i = 0; i < 8; i++) {
    qq[i] = *(const unsigned*)(p.gq + (size_t)(t0 + seg * 8 + i) * 512 + h * 64 + d0);
    kk[i] = *(const unsigned*)(p.gk + (size_t)(t0 + seg * 8 + i) * 512 + h * 64 + d0);
  }
  bf16x8 vf[2][2];
#pragma unroll
  for (int jt = 0; jt < 2; jt++)
#pragma unroll
    for (int s = 0; s < 2; s++) {
      const u16* base = p.gvT + (size_t)tok0 * 512 + (size_t)(h * 64 + 32 * wc + r) * T + s0 + 32 * jt + 16 * s + 4 * hh;
      uint2 lo = *(const uint2*)base, hi = *(const uint2*)(base + 8);
      u32x4 u; u[0] = lo.x; u[1] = lo.y; u[2] = hi.x; u[3] = hi.y;
      vf[jt][s] = __builtin_bit_cast(bf16x8, u);
    }
  float4 sp[2][8];
#pragma unroll
  for (int dir = 0; dir < 2; dir++) {
    const float* Sp = p.dS + ((size_t)it * 2 + dir) * 4096 + (32 * wc + r) * 64 + 8 * hh;
#pragma unroll
    for (int ks = 0; ks < 4; ks++) { sp[dir][2 * ks] = *(const float4*)(Sp + ks * 16); sp[dir][2 * ks + 1] = *(const float4*)(Sp + ks * 16 + 4); }
  }
  {
    const float4* bsrc = (const float4*)(p.Bst + (size_t)it * 2 * 4096);
    float4 tmp[8];
#pragma unroll
    for (int i = 0; i < 8; i++) tmp[i] = bsrc[tid + 256 * i];
#pragma unroll
    for (int i = 0; i < 8; i++) ((float4*)smem)[tid + 256 * i] = tmp[i];
  }
  __syncthreads();
#pragma unroll
  for (int dir = 0; dir < 2; dir++) {
    const float* Bs = (const float*)(smem + dir * 16384);
    char* Qt = smem + (dir ? 49152 : 32768);
    char* Kt = smem + (dir ? 57344 : 40960);
    const float tl0 = Bs[63 * 64 + d0], tl1 = Bs[63 * 64 + d0 + 1];
#pragma unroll
    for (int i = 0; i < 8; i++) {
      const int j = seg * 8 + i;
      float b0, b1;
      if (dir == 0) { b0 = Bs[j * 64 + d0]; b1 = Bs[j * 64 + d0 + 1]; }
      else {
        float p0 = j > 0 ? Bs[(j - 1) * 64 + d0] : 0.f, p1 = j > 0 ? Bs[(j - 1) * 64 + d0 + 1] : 0.f;
        b0 = tl0 - p0; b1 = tl1 - p1;
      }
      const float eq0 = __expf(b0), eq1 = __expf(b1), ek0 = __expf(-b0), ek1 = __expf(-b1);
      const int off = swz(j, dp >> 2) + (dp & 3) * 4;
      *(unsigned*)(Qt + off) = pack2(bflo(qq[i]) * eq0, bfhi(qq[i]) * eq1);
      *(unsigned*)(Kt + off) = pack2(bflo(kk[i]) * ek0, bfhi(kk[i]) * ek1);
    }
    __syncthreads();
  }
  f32x16 O;
#pragma unroll
  for (int q = 0; q < 16; q++) O[q] = 0.f;
#pragma unroll
  for (int dir = 0; dir < 2; dir++) {
    const char* Qt = smem + (dir ? 49152 : 32768);
    const char* Kt = smem + (dir ? 57344 : 40960);
    bf16x8 qf[4];
#pragma unroll
    for (int ks = 0; ks < 4; ks++) qf[ks] = *(const bf16x8*)(Qt + swz(32 * wr + r, ks * 2 + hh));
#pragma unroll
    for (int jt = 0; jt < 2; jt++) {
      const bool use = dir == 0 ? (jt <= wr) : (jt >= wr);
      if (use) {
        f32x16 X;
#pragma unroll
        for (int q = 0; q < 16; q++) X[q] = 0.f;
#pragma unroll
        for (int ks = 0; ks < 4; ks++) {
          bf16x8 a = *(const bf16x8*)(Kt + swz(32 * jt + r, ks * 2 + hh));
          X = MFMA32(a, qf[ks], X);
        }
        if (jt == wr) {
#pragma unroll
          for (int q = 0; q < 16; q++) {
            const int jl = crow(q, hh);
            const bool keep = dir == 0 ? (jl <= r) : (jl >= r);
            X[q] = keep ? X[q] : 0.f;
          }
        }
        O = MFMA32(vf[jt][0], PACKX(X, 0), O);
        O = MFMA32(vf[jt][1], PACKX(X, 1), O);
      }
    }
#pragma unroll
    for (int ks = 0; ks < 4; ks++) {
      const float4 a0 = sp[dir][2 * ks], a1 = sp[dir][2 * ks + 1];
      bf16x8 sa = pack8(a0.x, a0.y, a0.z, a0.w, a1.x, a1.y, a1.z, a1.w);
      O = MFMA32(sa, qf[ks], O);
    }
  }
  float ss = 0.f;
#pragma unroll
  for (int q = 0; q < 16; q++) ss += O[q] * O[q];
  ss += __shfl_xor(ss, 32);
  if (hh == 0) red[wc * 64 + 32 * wr + r] = ss;
  __syncthreads();
  const float rstd = rsqrtf((red[32 * wr + r] + red[64 + 32 * wr + r]) * (1.f / 64.f) + 1e-6f);
  const int t = t0 + 32 * wr + r;
#pragma unroll
  for (int g = 0; g < 4; g++) {
    const int e0 = 32 * wc + 8 * g + 4 * hh;
    const uint2 gv = *(const uint2*)(p.gg + (size_t)t * 512 + h * 64 + e0);
    const float4 gn = *(const float4*)(p.gla_norm + e0);
    float o0 = O[4 * g] * rstd * gn.x * silu_f(bflo(gv.x));
    float o1 = O[4 * g + 1] * rstd * gn.y * silu_f(bfhi(gv.x));
    float o2 = O[4 * g + 2] * rstd * gn.z * silu_f(bflo(gv.y));
    float o3 = O[4 * g + 3] * rstd * gn.w * silu_f(bfhi(gv.y));
    uint2 o; o.x = pack2(o0, o1); o.y = pack2(o2, o3);
    *(uint2*)(p.act + (size_t)t * DM + h * 64 + e0) = o;
  }
  __syncthreads();
}

#define N_ATT_ITEMS 384
__device__ void attn_item(const P& p, int it, char* smem) {
  const bool lat = it < 128;
  int b, kvh, qb, T, tok0, nloc, ntile;
  if (lat) { b = it >> 6; kvh = (it >> 5) & 1; qb = it & 31; T = 1024; tok0 = NCTX + b * 1024; nloc = 5; ntile = 13; }
  else { int u = it - 128; b = u >> 4; kvh = (u >> 3) & 1; qb = u & 7; T = 256; tok0 = b * 256; nloc = 4; ntile = 4; }
  const int q0 = qb * 32, kstart = lat ? q0 - 128 : 0;
  const int tid = opaque_tid(), lane = tid & 63, wv = tid >> 6, r = lane & 31, hh = lane >> 5;
  const int hd = kvh * 4 + wv;
  const int lrow = tid >> 3, lch = tid & 7;
  bf16x8 qf[4];
#pragma unroll
  for (int ks = 0; ks < 4; ks++) qf[ks] = *(const bf16x8*)(p.sq + (size_t)(tok0 + q0 + r) * 512 + hd * 64 + ks * 16 + 8 * hh);
  float m = p.sink[hd] * 1.44269504088896f;
  float l = hh == 0 ? 1.f : 0.f;
  const int klo = max(q0 + r - 128, 0);
  const unsigned kspan = (unsigned)(min(q0 + r + 128, T - 1) - klo);
  f32x16 ZERO16 = {0.f, 0.f, 0.f, 0.f, 0.f, 0.f, 0.f, 0.f, 0.f, 0.f, 0.f, 0.f, 0.f, 0.f, 0.f, 0.f};
  asm volatile("" : "+v"(ZERO16));
  f32x16 O[2];
#pragma unroll
  for (int q = 0; q < 16; q++) { O[0][q] = 0.f; O[1][q] = 0.f; }
  uint4 rk0, rk1, rv0, rv1;
#define ATT_LOAD(tt)                                                                                                    \
  do {                                                                                                                  \
    if ((tt) < nloc) {                                                                                                  \
      const int kb_ = kstart + (tt) * 64;                                                                               \
      const int k0_ = min(max(kb_ + lrow, 0), T - 1), k1_ = min(max(kb_ + lrow + 32, 0), T - 1);                         \
      rk0 = *(const uint4*)(p.sk + (size_t)(tok0 + k0_) * 128 + kvh * 64 + lch * 8);                                    \
      rk1 = *(const uint4*)(p.sk + (size_t)(tok0 + k1_) * 128 + kvh * 64 + lch * 8);                                    \
      const int kv0_ = kb_ + lch * 8;                                                                                   \
      rv0 = make_uint4(0u, 0u, 0u, 0u); rv1 = rv0;                                                                      \
      if (kv0_ >= 0 && kv0_ < T) {                                                                                      \
        rv0 = *(const uint4*)(p.svT + (size_t)tok0 * 128 + (size_t)(kvh * 64 + lrow) * T + kv0_);                       \
        rv1 = *(const uint4*)(p.svT + (size_t)tok0 * 128 + (size_t)(kvh * 64 + lrow + 32) * T + kv0_);                  \
      }                                                                                                                 \
    } else {                                                                                                            \
      const int kb_ = ((tt) - nloc) * 64;                                                                               \
      rk0 = *(const uint4*)(p.ckb + ((size_t)(b * 2 + kvh) * 512 + kb_ + lrow) * 64 + lch * 8);                         \
      rk1 = *(const uint4*)(p.ckb + ((size_t)(b * 2 + kvh) * 512 + kb_ + lrow + 32) * 64 + lch * 8);                    \
      rv0 = *(const uint4*)(p.cvT + ((size_t)(b * 2 + kvh) * 64 + lrow) * 512 + kb_ + lch * 8);                         \
      rv1 = *(const uint4*)(p.cvT + ((size_t)(b * 2 + kvh) * 64 + lrow + 32) * 512 + kb_ + lch * 8);                    \
    }                                                                                                                   \
  } while (0)
#define ATT_STORE(buf)                                                                                                  \
  do {                                                                                                                  \
    char* sK_ = smem + (buf) * 16384;                                                                                   \
    const int o0_ = swz(lrow, lch), o1_ = swz(lrow + 32, lch);                                                          \
    *(uint4*)(sK_ + o0_) = rk0; *(uint4*)(sK_ + o1_) = rk1;                                                             \
    *(uint4*)(sK_ + 8192 + o0_) = rv0; *(uint4*)(sK_ + 8192 + o1_) = rv1;                                               \
  } while (0)
  ATT_LOAD(0);
  ATT_STORE(0);
  __syncthreads();
  for (int tt = 0; tt < ntile; tt++) {
    const char* sK = smem + (tt & 1) * 16384;
    const char* sV = sK + 8192;
    if (tt + 1 < ntile) ATT_LOAD(tt + 1);
    f32x16 X[2];
#pragma unroll
    for (int sub = 0; sub < 2; sub++) {
      X[sub] = MFMA32(*(const bf16x8*)(sK + swz(32 * sub + r, hh)), qf[0], ZERO16);
#pragma unroll
      for (int ks = 1; ks < 4; ks++) {
        bf16x8 a = *(const bf16x8*)(sK + swz(32 * sub + r, ks * 2 + hh));
        X[sub] = MFMA32(a, qf[ks], X[sub]);
      }
    }
    const int kb0 = kstart + tt * 64;
    if (lat && tt < nloc && (kb0 < q0 - 97 || kb0 + 63 > q0 + 128 || kb0 < 0 || kb0 + 63 >= T)) {
      const int base = kb0 - klo;
#pragma unroll
      for (int sub = 0; sub < 2; sub++)
#pragma unroll
        for (int q = 0; q < 16; q++) {
          const unsigned rel = (unsigned)(base + 32 * sub + crow(q, hh));
          X[sub][q] = rel <= kspan ? X[sub][q] : -1e30f;
        }
    }
    float mx = fmaxf(X[0][0], X[1][0]);
#pragma unroll
    for (int q = 1; q < 16; q++) mx = fmaxf(fmaxf(mx, X[0][q]), X[1][q]);
    mx = fmaxf(mx, __shfl_xor(mx, 32));
    if (__any(mx > m + 8.f)) {
      const float mn = fmaxf(m, mx);
      const float alpha = __builtin_amdgcn_exp2f(m - mn);
      m = mn;
      l *= alpha;
#pragma unroll
      for (int q = 0; q < 16; q++) { O[0][q] *= alpha; O[1][q] *= alpha; }
    }
    float ps = 0.f;
#pragma unroll
    for (int sub = 0; sub < 2; sub++)
#pragma unroll
      for (int q = 0; q < 16; q++) {
        float pv = __builtin_amdgcn_exp2f(X[sub][q] - m);
        X[sub][q] = pv;
        ps += pv;
      }
    l += ps;
#pragma unroll
    for (int sub = 0; sub < 2; sub++)
#pragma unroll
      for (int s = 0; s < 2; s++) {
        const bf16x8 pb = s == 0 ? PACKX(X[sub], 0) : PACKX(X[sub], 1);
#pragma unroll
        for (int dt = 0; dt < 2; dt++) {
          const int row = 32 * dt + r;
          const int ch = 4 * sub + 2 * s;
          uint2 lo = *(const uint2*)(sV + swz(row, ch) + 8 * hh);
          uint2 hi = *(const uint2*)(sV + swz(row, ch + 1) + 8 * hh);
          u32x4 u; u[0] = lo.x; u[1] = lo.y; u[2] = hi.x; u[3] = hi.y;
          O[dt] = MFMA32(__builtin_bit_cast(bf16x8, u), pb, O[dt]);
        }
      }
    if (tt + 1 < ntile) ATT_STORE((tt + 1) & 1);
    __syncthreads();
  }
  l += __shfl_xor(l, 32);
  const float inv = 1.f / l;
  const int t = tok0 + q0 + r;
#pragma unroll
  for (int dt = 0; dt < 2; dt++)
#pragma unroll
    for (int g = 0; g < 4; g++) {
      const int dd = 32 * dt + 8 * g + 4 * hh;
      uint2 o;
      o.x = pack2(O[dt][4 * g] * inv, O[dt][4 * g + 1] * inv);
      o.y = pack2(O[dt][4 * g + 2] * inv, O[dt][4 * g + 3] * inv);
      *(uint2*)(p.act + (size_t)t * DM + 512 + hd * 64 + dd) = o;
    }
}

#define SCQ (0.125f * 1.44269504088896f)
struct EpiProj {
  const P& p;
  __device__ __forceinline__ void operator()(f32x16 (&acc)[2][2], int rb, int cb, int lr, int lh) const {
    const int n64 = cb >> 6;
    int tok0, T, s0;
    tok_seq(rb, tok0, T, s0);
    const bool lat = rb >= NCTX;
    if (n64 < 16 || (n64 >= 24 && n64 < 32)) {
      u16* dst = n64 < 8 ? p.gq : (n64 < 16 ? p.gk : p.gg);
      const float sc = n64 < 8 ? 0.125f : 1.f;
      const int c = (n64 & 7) * 64 + lr;
#pragma unroll
      for (int mi = 0; mi < 2; mi++)
#pragma unroll
        for (int ni = 0; ni < 2; ni++)
#pragma unroll
          for (int q = 0; q < 16; q++)
            dst[(size_t)(rb + mi * 32 + crow(q, lh)) * 512 + c + ni * 32] = f2bf(acc[mi][ni][q] * sc);
    } else if (n64 < 24) {
      const int h = n64 - 16;
#pragma unroll
      for (int mi = 0; mi < 2; mi++)
#pragma unroll
        for (int ni = 0; ni < 2; ni++) {
          u16* dst = p.gvT + (size_t)tok0 * 512 + (size_t)(h * 64 + ni * 32 + lr) * T + s0 + mi * 32 + 4 * lh;
#pragma unroll
          for (int g = 0; g < 4; g++) {
            uint2 o;
            o.x = pack2(acc[mi][ni][4 * g], acc[mi][ni][4 * g + 1]);
            o.y = pack2(acc[mi][ni][4 * g + 2], acc[mi][ni][4 * g + 3]);
            *(uint2*)(dst + 8 * g) = o;
          }
        }
    } else if (n64 < 42) {
      const bool isq = n64 < 40;
      const float* gain = isq ? p.q_norm : p.k_norm;
      const float g0 = gain[lr], g1 = gain[32 + lr];
      const int hb = isq ? (n64 - 32) * 64 : (n64 - 40) * 64;
#pragma unroll
      for (int mi = 0; mi < 2; mi++)
#pragma unroll
        for (int q = 0; q < 16; q++) {
          float v0 = acc[mi][0][q], v1 = acc[mi][1][q];
          float ss = v0 * v0 + v1 * v1;
          ss += __shfl_xor(ss, 1); ss += __shfl_xor(ss, 2); ss += __shfl_xor(ss, 4); ss += __shfl_xor(ss, 8); ss += __shfl_xor(ss, 16);
          const float rstd = rsqrtf(ss * (1.f / 64.f) + 1e-6f);
          v0 *= rstd * g0; v1 *= rstd * g1;
          const int s = s0 + mi * 32 + crow(q, lh);
          const int t = rb + mi * 32 + crow(q, lh);
          if (lat) {
            const float pa0 = __shfl_xor(v0, 16), pa1 = __shfl_xor(v1, 16);
            const float2 c0 = p.rope[(s >> 6) * 16 + (lr & 15)], c1 = p.rope[(s & 63) * 16 + (lr & 15)];
            v0 = (lr & 16) ? (v0 * c0.x + pa0 * c0.y) : (v0 * c0.x - pa0 * c0.y);
            v1 = (lr & 16) ? (v1 * c1.x + pa1 * c1.y) : (v1 * c1.x - pa1 * c1.y);
          }
          if (isq) {
            p.sq[(size_t)t * 512 + hb + lr] = f2bf(v0 * SCQ);
            p.sq[(size_t)t * 512 + hb + 32 + lr] = f2bf(v1 * SCQ);
          } else {
            p.sk[(size_t)t * 128 + hb + lr] = f2bf(v0);
            p.sk[(size_t)t * 128 + hb + 32 + lr] = f2bf(v1);
            if (!lat) {
              float* o = p.out + 6291456 + ((size_t)((rb >> 8) * 2 + (n64 - 40)) * 256 + s) * 64;
              o[lr] = v0; o[32 + lr] = v1;
            }
          }
        }
    } else if (n64 < 44) {
      const int kvh = n64 - 42;
#pragma unroll
      for (int mi = 0; mi < 2; mi++)
#pragma unroll
        for (int ni = 0; ni < 2; ni++) {
          u16* dst = p.svT + (size_t)tok0 * 128 + (size_t)(kvh * 64 + ni * 32 + lr) * T + s0 + mi * 32 + 4 * lh;
#pragma unroll
          for (int g = 0; g < 4; g++) {
            uint2 o;
            o.x = pack2(acc[mi][ni][4 * g], acc[mi][ni][4 * g + 1]);
            o.y = pack2(acc[mi][ni][4 * g + 2], acc[mi][ni][4 * g + 3]);
            *(uint2*)(dst + 8 * g) = o;
          }
          if (!lat) {
#pragma unroll
            for (int q = 0; q < 16; q++) {
              const int s = s0 + mi * 32 + crow(q, lh);
              p.out[6815744 + ((size_t)((rb >> 8) * 2 + kvh) * 256 + s) * 64 + ni * 32 + lr] = acc[mi][ni][q];
            }
          }
        }
    } else if (n64 == 44) {
#pragma unroll
      for (int mi = 0; mi < 2; mi++)
#pragma unroll
        for (int q = 0; q < 16; q++) p.lr[(size_t)(rb + mi * 32 + crow(q, lh)) * 32 + lr] = acc[mi][0][q];
    }
  }
};
__device__ __forceinline__ void stage_rows16(char* wsm, u16* dst, size_t ld) {
  const int lane = threadIdx.x & 63, r0 = lane >> 3, ch = lane & 7;
  __builtin_amdgcn_wave_barrier();
#pragma unroll
  for (int i = 0; i < 8; i++) {
    const int row = r0 + 8 * i;
    *(uint4*)(dst + (size_t)row * ld + ch * 8) = *(const uint4*)(wsm + row * 144 + ch * 16);
  }
}
struct EpiGG16 {
  u16* gg;
  char* smem;
  __device__ __forceinline__ void operator()(f32x4 (&acc)[4][4], int rb, int cb, int r16, int quad) const {
    char* wsm = smem + (threadIdx.x >> 6) * 9216;
#pragma unroll
    for (int mi = 0; mi < 4; mi++)
#pragma unroll
      for (int ni = 0; ni < 4; ni++)
#pragma unroll
        for (int j = 0; j < 4; j++) *(u16*)(wsm + (mi * 16 + quad * 4 + j) * 144 + (ni * 16 + r16) * 2) = f2bf(acc[mi][ni][j]);
    stage_rows16(wsm, gg + (size_t)rb * 512 + ((cb >> 6) & 7) * 64, 512);
    __syncthreads();
  }
};
struct EpiProj16 {
  const P& p;
  char* smem;
  __device__ __forceinline__ void operator()(f32x4 (&acc)[4][4], int rb, int cb, int r16, int quad) const {
    const int n64 = cb >> 6;
    int tok0, T, s0;
    tok_seq(rb, tok0, T, s0);
    const bool lat = rb >= NCTX;
    char* wsm = smem + (threadIdx.x >> 6) * 9216;
    if (n64 < 16 || (n64 >= 24 && n64 < 32)) {
      u16* dst = n64 < 8 ? p.gq : (n64 < 16 ? p.gk : p.gg);
      const float sc = n64 < 8 ? 0.125f : 1.f;
#pragma unroll
      for (int mi = 0; mi < 4; mi++)
#pragma unroll
        for (int ni = 0; ni < 4; ni++)
#pragma unroll
          for (int j = 0; j < 4; j++) *(u16*)(wsm + (mi * 16 + quad * 4 + j) * 144 + (ni * 16 + r16) * 2) = f2bf(acc[mi][ni][j] * sc);
      stage_rows16(wsm, dst + (size_t)rb * 512 + (n64 & 7) * 64, 512);
    } else if (n64 < 24 || (n64 >= 42 && n64 < 44)) {
      const bool isg = n64 < 24;
      const int hb = isg ? (n64 - 16) * 64 : (n64 - 42) * 64;
      u16* base = isg ? p.gvT + (size_t)tok0 * 512 : p.svT + (size_t)tok0 * 128;
#pragma unroll
      for (int mi = 0; mi < 4; mi++)
#pragma unroll
        for (int ni = 0; ni < 4; ni++) {
          uint2 o;
          o.x = pack2(acc[mi][ni][0], acc[mi][ni][1]);
          o.y = pack2(acc[mi][ni][2], acc[mi][ni][3]);
          *(uint2*)(base + (size_t)(hb + ni * 16 + r16) * T + s0 + mi * 16 + quad * 4) = o;
          if (!isg && !lat) {
#pragma unroll
            for (int j = 0; j < 4; j++) {
              const int s = s0 + mi * 16 + quad * 4 + j;
              st_nt(p.out + 6815744 + ((size_t)((rb >> 8) * 2 + (n64 - 42)) * 256 + s) * 64 + ni * 16 + r16, acc[mi][ni][j]);
            }
          }
        }
    } else if (n64 < 42) {
      const bool isq = n64 < 40;
      const float* gain = isq ? p.q_norm : p.k_norm;
      float g[4];
#pragma unroll
      for (int ni = 0; ni < 4; ni++) g[ni] = gain[ni * 16 + r16];
#pragma unroll
      for (int mi = 0; mi < 4; mi++)
#pragma unroll
        for (int j = 0; j < 4; j++) {
          float v[4];
          float ss = 0.f;
#pragma unroll
          for (int ni = 0; ni < 4; ni++) { v[ni] = acc[mi][ni][j]; ss += v[ni] * v[ni]; }
          ss += __shfl_xor(ss, 1); ss += __shfl_xor(ss, 2); ss += __shfl_xor(ss, 4); ss += __shfl_xor(ss, 8);
          const float rstd = rsqrtf(ss * (1.f / 64.f) + 1e-6f);
#pragma unroll
          for (int ni = 0; ni < 4; ni++) v[ni] *= rstd * g[ni];
          const int rl = mi * 16 + quad * 4 + j, s = s0 + rl;
          if (lat) {
            const float2 c0 = p.rope[(s >> 6) * 16 + r16], c1 = p.rope[(s & 63) * 16 + r16];
            const float a0 = v[0] * c0.x - v[1] * c0.y, a1 = v[1] * c0.x + v[0] * c0.y;
            const float a2 = v[2] * c1.x - v[3] * c1.y, a3 = v[3] * c1.x + v[2] * c1.y;
            v[0] = a0; v[1] = a1; v[2] = a2; v[3] = a3;
          }
          const float osc = isq ? SCQ : 1.f;
#pragma unroll
          for (int ni = 0; ni < 4; ni++) *(u16*)(wsm + rl * 144 + (ni * 16 + r16) * 2) = f2bf(v[ni] * osc);
          if (!isq && !lat) {
            float* o = p.out + 6291456 + ((size_t)((rb >> 8) * 2 + (n64 - 40)) * 256 + s) * 64 + r16;
#pragma unroll
            for (int ni = 0; ni < 4; ni++) st_nt(o + ni * 16, v[ni]);
          }
          __builtin_amdgcn_sched_barrier(0);
        }
      if (isq) stage_rows16(wsm, p.sq + (size_t)rb * 512 + (n64 - 32) * 64, 512);
      else stage_rows16(wsm, p.sk + (size_t)rb * 128 + (n64 - 40) * 64, 128);
    } else if (n64 == 44) {
#pragma unroll
      for (int mi = 0; mi < 4; mi++)
#pragma unroll
        for (int ni = 0; ni < 2; ni++)
#pragma unroll
          for (int j = 0; j < 4; j++) p.lr[(size_t)(rb + mi * 16 + quad * 4 + j) * 32 + ni * 16 + r16] = acc[mi][ni][j];
    }
    __syncthreads();
  }
};
struct EpiGG {
  u16* gg;
  __device__ __forceinline__ void operator()(f32x16 (&acc)[2][2], int rb, int cb, int lr, int lh) const {
    const int c = ((cb >> 6) & 7) * 64 + lr;
#pragma unroll
    for (int mi = 0; mi < 2; mi++)
#pragma unroll
      for (int ni = 0; ni < 2; ni++)
#pragma unroll
        for (int q = 0; q < 16; q++) gg[(size_t)(rb + mi * 32 + crow(q, lh)) * 512 + c + ni * 32] = f2bf(acc[mi][ni][q]);
  }
};
struct EpiWo {
  const P& p;
  template <int MI, int NI>
  __device__ __forceinline__ void operator()(f32x16 (&acc)[MI][NI], int rb, int cb, int lr, int lh) const {
#pragma unroll
    for (int mi = 0; mi < MI; mi++) {
      const float* md = p.mod + tok_cond(rb + mi * 32) * MODN + 2048 + cb + lr;
#pragma unroll
      for (int ni = 0; ni < NI; ni++) {
        const float g = md[ni * 32];
#pragma unroll
        for (int q = 0; q < 16; q++) {
          const int t = rb + mi * 32 + crow(q, lh);
          p.x1[(size_t)t * DM + cb + ni * 32 + lr] = f2bf(xrow(p, t)[cb + ni * 32 + lr] + g * acc[mi][ni][q]);
        }
      }
    }
  }
};
struct EpiFF1 {
  u16* hid;
  template <int MI, int NI>
  __device__ __forceinline__ void operator()(f32x16 (&acc)[MI][NI], int rb, int cb, int lr, int lh) const {
#pragma unroll
    for (int mi = 0; mi < MI; mi++)
#pragma unroll
      for (int ni = 0; ni < NI; ni++)
#pragma unroll
        for (int q = 0; q < 16; q++) {
          float t = fmaxf(acc[mi][ni][q], 0.f);
          hid[(size_t)(rb + mi * 32 + crow(q, lh)) * DFF + cb + ni * 32 + lr] = f2bf(t * t);
        }
  }
};
#define ST_ROWB 144
struct EpiFF1x16 {
  u16* hid;
  char* smem;
  __device__ __forceinline__ void operator()(f32x4 (&acc)[4][4], int rb, int cb, int r16, int quad) const {
    char* wsm = smem + (threadIdx.x >> 6) * (64 * ST_ROWB);
#pragma unroll
    for (int mi = 0; mi < 4; mi++)
#pragma unroll
      for (int ni = 0; ni < 4; ni++)
#pragma unroll
        for (int j = 0; j < 4; j++) {
          float t = fmaxf(acc[mi][ni][j], 0.f);
          *(u16*)(wsm + (mi * 16 + quad * 4 + j) * ST_ROWB + (ni * 16 + r16) * 2) = f2bf(t * t);
        }
    __builtin_amdgcn_wave_barrier();
    const int lane = threadIdx.x & 63, r0 = lane >> 3, ch = lane & 7;
    u16* dst = hid + (size_t)rb * DFF + cb;
#pragma unroll
    for (int i = 0; i < 8; i++) {
      const int row = r0 + 8 * i;
      *(uint4*)(dst + (size_t)row * DFF + ch * 8) = *(const uint4*)(wsm + row * ST_ROWB + ch * 16);
    }
    __syncthreads();
  }
};
struct EpiWo16 {
  const P& p;
  char* smem;
  template <int MT, int NT>
  __device__ __forceinline__ void operator()(f32x4 (&acc)[MT][NT], int rb, int cb, int r16, int quad) const {
    const int cl0 = cb & 127, rl0 = rb % 96;
#pragma unroll
    for (int mi = 0; mi < MT; mi++) {
      const float* md = p.mod + tok_cond(rb + mi * 16) * MODN + 2048 + cb + r16;
#pragma unroll
      for (int ni = 0; ni < NT; ni++) {
        const float g = md[ni * 16];
#pragma unroll
        for (int j = 0; j < 4; j++) {
          const int rl = mi * 16 + quad * 4 + j;
          const float v = __builtin_nontemporal_load(xrow(p, rb + rl) + cb + ni * 16 + r16) + g * acc[mi][ni][j];
          *(u16*)(smem + (rl0 + rl) * 272 + (cl0 + ni * 16 + r16) * 2) = f2bf(v);
        }
      }
    }
    __syncthreads();
    u16* dst = p.x1 + (size_t)(rb - rl0) * DM + (cb & ~127);
#pragma unroll
    for (int i = 0; i < 6; i++) {
      const int id = threadIdx.x + 256 * i, row = id >> 4, c16 = id & 15;
      *(uint4*)(dst + (size_t)row * DM + c16 * 8) = *(const uint4*)(smem + row * 272 + c16 * 16);
    }
    __syncthreads();
  }
};
struct EpiFF2x16 {
  const P& p;
  template <int MT, int NT>
  __device__ __forceinline__ void operator()(f32x4 (&acc)[MT][NT], int rb, int cb, int r16, int quad) const {
#pragma unroll
    for (int mi = 0; mi < MT; mi++) {
      const float* md = p.mod + tok_cond(rb + mi * 16) * MODN + 5120 + cb + r16;
#pragma unroll
      for (int ni = 0; ni < NT; ni++) {
        const float g = md[ni * 16];
#pragma unroll
        for (int j = 0; j < 4; j++) {
          const size_t o = (size_t)(rb + mi * 16 + quad * 4 + j) * DM + cb + ni * 16 + r16;
          st_nt(p.out + o, bf2f(p.x1[o]) + g * acc[mi][ni][j]);
        }
      }
    }
  }
};
struct EpiFF2 {
  const P& p;
  template <int MI, int NI>
  __device__ __forceinline__ void operator()(f32x16 (&acc)[MI][NI], int rb, int cb, int lr, int lh) const {
#pragma unroll
    for (int mi = 0; mi < MI; mi++) {
      const float* md = p.mod + tok_cond(rb + mi * 32) * MODN + 5120 + cb + lr;
#pragma unroll
      for (int ni = 0; ni < NI; ni++) {
        const float g = md[ni * 32];
#pragma unroll
        for (int q = 0; q < 16; q++) {
          const size_t o = (size_t)(rb + mi * 32 + crow(q, lh)) * DM + cb + ni * 32 + lr;
          st_nt(p.out + o, bf2f(p.x1[o]) + g * acc[mi][ni][q]);
        }
      }
    }
  }
};

__device__ void phase_attn_gla1(const P& p, char* smem, volatile unsigned* slot) {
  const int nsh = (gridDim.x & 7) == 0 ? 8 : 1, sh = nsh == 8 ? (int)(blockIdx.x & 7) : 0;
  unsigned* ctr = p.bar + QWORDS1 + sh * 64;
  unsigned nxt = 0;
  if (threadIdx.x == 0) nxt = atomicAdd(ctr, 1u);
  for (;;) {
    __syncthreads();
    if (threadIdx.x == 0) *slot = nxt;
    __syncthreads();
    const int it = (int)*slot * nsh + sh;
    if (it >= 192 + N_ATT_ITEMS + 768) break;
    if (threadIdx.x == 0) nxt = atomicAdd(ctr, 1u);
    if (it < 192) {
      gemm_glds16<4, 4, 2, 2>(p.hbuf, p.WinT, NTOK, NPROJ, 1024, EpiGG16{p.gg, smem}, 12 * 48 + it, 1 << 30, smem);
    } else if (it < 192 + N_ATT_ITEMS) attn_item(p, it - 192, smem);
    else gla_pass1_item(p, it - 192 - N_ATT_ITEMS, smem);
  }
}
__device__ void phase_scan(const P& p, int bid, int nblk) {
  for (int it = bid; it < 1152; it += nblk) gla_scan_item(p, it);
}
__device__ void phase_gla2(const P& p, int bid, int nblk, char* smem) {
  for (int it = bid; it < 768; it += nblk) gla_pass2_item(p, it, smem);
}


#define XB_TMO      128
#define XB_XCNT(j)  (256  + 64 * (j))
#define XB_XSUB(j)  (1280 + 64 * (j))
#define XB_XGEN(j)  (2304 + 64 * (j))
#define XB_TOP      3328
#define XB_TOPGEN   3392
#define XB_SPIN_CAP (1u << 18)
#define LAS __attribute__((address_space(3)))
__device__ __forceinline__ unsigned xb_ld(unsigned* p) { return __hip_atomic_load(p, __ATOMIC_RELAXED, __HIP_MEMORY_SCOPE_AGENT); }
__device__ __forceinline__ unsigned xb_add(unsigned* p, unsigned v) { return __hip_atomic_fetch_add(p, v, __ATOMIC_RELAXED, __HIP_MEMORY_SCOPE_AGENT); }
__device__ __forceinline__ unsigned xb_xcc_id() { return (unsigned)__builtin_amdgcn_s_getreg((3 << 11) | 20) & 0xFu; }
#define XB_SPIN(cond, bar) do { unsigned _sp = 0; while (cond) { __builtin_amdgcn_s_sleep(1); \
    if ((++_sp & 255u) == 0u) { if (xb_ld(&(bar)[XB_TMO])) break; if (_sp > XB_SPIN_CAP) { atomicAdd(&(bar)[XB_TMO], 1u); break; } } } } while (0)
struct XcdBarrier { unsigned* bar; unsigned x; volatile LAS unsigned* st; };
__device__ __forceinline__ XcdBarrier xcd_barrier_post(unsigned* bar, volatile LAS unsigned* st) {
  XcdBarrier b; b.bar = bar; b.x = xb_xcc_id(); b.st = st;
  if (threadIdx.x == 0) (void)xb_add(&bar[XB_XCNT(b.x)], 1u);
  return b;
}
__device__ __forceinline__ void xcd_barrier_complete(unsigned* bar, unsigned x, unsigned& nloc, unsigned& nx) {
  const unsigned G = gridDim.x * gridDim.y * gridDim.z;
  unsigned sum, cnt, mine, sp = 0u;
  for (;;) {
    sum = 0u; cnt = 0u; mine = 0u;
#pragma unroll
    for (unsigned j = 0; j < 16; ++j) { const unsigned c = xb_ld(&bar[XB_XCNT(j)]); sum += c; cnt += (c > 0u) ? 1u : 0u; mine = (j == x) ? c : mine; }
    if (sum == G) break;
    __builtin_amdgcn_s_sleep(1);
    if ((++sp & 255u) == 0u) { if (xb_ld(&bar[XB_TMO])) break; if (sp > XB_SPIN_CAP) { atomicAdd(&bar[XB_TMO], 1u); break; } }
  }
  nloc = mine > 0u ? mine : 1u; nx = cnt > 0u ? cnt : 1u;
}
__device__ __forceinline__ void xcd_barrier(const XcdBarrier& b) {
  asm volatile("s_waitcnt vmcnt(0)" ::: "memory");
  __syncthreads();
  if (threadIdx.x == 0) {
    unsigned* bar = b.bar;
    __builtin_amdgcn_s_waitcnt(0);
    unsigned nloc = b.st[0], nx = b.st[1];
    if (nloc == 0u) { xcd_barrier_complete(bar, b.x, nloc, nx); b.st[0] = nloc; b.st[1] = nx; }
    const unsigned old = xb_add(&bar[XB_XSUB(b.x)], 1u);
    const unsigned gen = old / nloc;
    if (old + 1u == (gen + 1u) * nloc) {
      __builtin_amdgcn_fence(__ATOMIC_RELEASE, "agent");
      asm volatile("s_waitcnt vmcnt(0)" ::: "memory");
      const unsigned og = xb_add(&bar[XB_TOP], 1u);
      const unsigned tg = og / nx;
      if (og + 1u == (tg + 1u) * nx) xb_add(&bar[XB_TOPGEN], 1u);
      else XB_SPIN(xb_ld(&bar[XB_TOPGEN]) == tg, bar);
      __builtin_amdgcn_fence(__ATOMIC_ACQUIRE, "agent");
      xb_add(&bar[XB_XGEN(b.x)], 1u);
      asm volatile("s_waitcnt vmcnt(0)" ::: "memory");
    } else {
      XB_SPIN(xb_ld(&bar[XB_XGEN(b.x)]) == gen, bar);
      __builtin_amdgcn_fence(__ATOMIC_ACQUIRE, "agent");
      asm volatile("s_waitcnt vmcnt(0)" ::: "memory");
    }
  }
  __syncthreads();
}

__global__ void __launch_bounds__(256, 2) mega_kernel(P p) {
  __shared__ __attribute__((aligned(1024))) float sm[16384 + 4];
  float* xbw = sm + 16384;
  cg::grid_group grid = cg::this_grid();
  if (p.never) grid.sync();
  if (threadIdx.x == 0) { xbw[0] = 0.f; xbw[1] = 0.f; xbw[2] = 0.f; xbw[3] = 0.f; }
  __syncthreads();
  XcdBarrier xb = xcd_barrier_post(p.bar, (volatile LAS unsigned*)xbw);
  const int bid = blockIdx.x, nblk = gridDim.x;
  char* smem = (char*)sm;
  phase0(p, bid, nblk, sm);
  xcd_barrier(xb);
  adaln_pass(p, 0, bid, nblk);
  xcd_barrier(xb);
  { EpiProj16 e{p, smem}; gemm_glds16<4, 4, 2, 2>(p.hbuf, p.WinT, NTOK, NPROJ, 1024, e, bid, nblk, smem, 12, 4); }
  phase_queue(p, sm, ((volatile unsigned*)xbw) + 2);
  xcd_barrier(xb);
  phase_attn_gla1(p, smem, ((volatile unsigned*)xbw) + 2);
  xcd_barrier(xb);
  phase_scan(p, bid, nblk);
  xcd_barrier(xb);
  phase_gla2(p, bid, nblk, smem);
  xcd_barrier(xb);
  { EpiWo16 e{p, smem}; gemm_glds16<3, 4, 2, 2>(p.act, p.WoT, NTOK, 1024, 1024, e, bid, nblk, smem); }
  xcd_barrier(xb);
  adaln_pass(p, 1, bid, nblk);
  xcd_barrier(xb);
  { EpiFF1x16 e{p.hid, smem}; gemm_glds16<4, 4, 2, 2>(p.hbuf, p.W1T, NTOK, 4096, 1024, e, bid, nblk, smem, 1 << 30, 0, true); }
  xcd_barrier(xb);
  { EpiFF2x16 e{p}; gemm_glds16<3, 4, 2, 2>(p.hid, p.W2T, NTOK, 1024, 4096, e, bid, nblk, smem); }
}

static inline size_t align_up(size_t x) { return (x + 255) & ~(size_t)255; }

extern "C" void kernel_launch(void* const* d_in, const int* in_sizes, int n_in, void* d_out, int out_size, void* d_ws,
                              size_t ws_size, hipStream_t stream) {
  P p{};
  const float** f = (const float**)&p;
  for (int i = 0; i < 24; i++) f[i] = (const float*)d_in[i];
  p.out = (float*)d_out;
  char* w = (char*)d_ws;
  size_t off = 0;
  auto take = [&](size_t bytes) { void* r = w + off; off += align_up(bytes); return r; };
  p.WinT = (u16*)take((size_t)NPROJ * 1024 * 2);
  p.WoT = (u16*)take((size_t)1024 * 1024 * 2);
  p.W1T = (u16*)take((size_t)4096 * 1024 * 2);
  p.W2T = (u16*)take((size_t)1024 * 4096 * 2);
  p.hbuf = (u16*)take((size_t)NTOK * 1024 * 2);
  p.gq = (u16*)take((size_t)NTOK * 512 * 2);
  p.gk = (u16*)take((size_t)NTOK * 512 * 2);
  p.gvT = (u16*)take((size_t)NTOK * 512 * 2);
  p.gg = (u16*)take((size_t)NTOK * 512 * 2);
  p.sq = (u16*)take((size_t)NTOK * 512 * 2);
  p.sk = (u16*)take((size_t)NTOK * 128 * 2);
  p.svT = (u16*)take((size_t)NTOK * 128 * 2);
  p.ckb = (u16*)take((size_t)2 * 2 * 512 * 64 * 2);
  p.cvT = (u16*)take((size_t)2 * 2 * 512 * 64 * 2);
  p.act = (u16*)take((size_t)NTOK * 1024 * 2);
  p.mod = (float*)take((size_t)3 * MODN * 4);
  p.mod2 = (float*)take((size_t)3 * 2048 * 4);
  p.lr = (float*)take((size_t)NTOK * 32 * 4);
  p.dS = (float*)take((size_t)1536 * 4096 * 4);
  p.dec = (float*)take((size_t)1536 * 64 * 4);
  p.Bst = (float*)take((size_t)1536 * 4096 * 4);
  p.x1 = (u16*)take((size_t)NTOK * 1024 * 2);
  p.hid = (u16*)take((size_t)NTOK * 4096 * 2);
  p.rope = (float2*)take((size_t)1024 * 8);
  p.bar = (unsigned*)take((size_t)BAR_WORDS_TOTAL * 4);
  p.never = 0; p.pad_ = 0;
  (void)ws_size; (void)in_sizes; (void)n_in; (void)out_size;

  static int grid_blocks = 0;
  if (!grid_blocks) {
    int dev = 0, cus = 0, per_cu = 0;
    hipGetDevice(&dev);
    hipDeviceGetAttribute(&cus, hipDeviceAttributeMultiprocessorCount, dev);
    hipOccupancyMaxActiveBlocksPerMultiprocessor(&per_cu, mega_kernel, 256, 0);
    if (per_cu > 2) per_cu = 2;
    if (per_cu < 1) per_cu = 1;
    grid_blocks = cus * per_cu;
  }
  hipMemsetAsync(p.bar, 0, (size_t)BAR_WORDS_TOTAL * 4, stream);
  void* args[] = {&p};
  hipError_t e = hipLaunchCooperativeKernel((void*)mega_kernel, dim3(grid_blocks), dim3(256), args, 0, stream);
  if (e != hipSuccess) fprintf(stderr, "cooperative launch failed: %s (grid %d)\n", hipGetErrorString(e), grid_blocks);
}
```
